# Optimizing an MI355X kernel written in HIP

```python
import math
import jax, jax.numpy as jnp
from jax import lax
import numpy as np

D_MODEL = 1024
BATCH = 8
SEQ = 2048
DEPTH = 2

N_META = 16
BLOCK = 128
MLA_HEADS = 4
Q_LORA = 256
KV_LORA = 256
QK_NOPE = 128
QK_ROPE = 64
QK_HEAD = QK_NOPE + QK_ROPE
V_HEAD = 128
MLA_WIDTH = MLA_HEADS * V_HEAD
RET_HEADS = 4
RET_HEAD = 128
RET_WIDTH = RET_HEADS * RET_HEAD
MIX_WIDTH = MLA_WIDTH + RET_WIDTH
IN_SIZES = (Q_LORA, KV_LORA, QK_ROPE, RET_WIDTH, RET_WIDTH, RET_WIDTH, RET_WIDTH)
N_IN = sum(IN_SIZES)
D_FF = -(-(8 * D_MODEL) // (3 * 256)) * 256
ROPE_BASE = 10000.0
EPS = 1e-6
NEG_INF = -1e30

kernel_name = "hybrid_mla_retention_swiglu"


def rms_norm(x, g):
    xf = x.astype(jnp.float32)
    y = xf * lax.rsqrt(jnp.mean(xf * xf, axis=-1, keepdims=True) + EPS)
    return (y * g.astype(jnp.float32)).astype(x.dtype)


def rope_tables(n_pos, dim):
    inv = ROPE_BASE ** (-jnp.arange(0, dim, 2, dtype=jnp.float32) / dim)
    ang = jnp.arange(n_pos, dtype=jnp.float32)[:, None] * inv[None, :]
    return jnp.cos(ang), jnp.sin(ang)


def apply_rope(x, cos, sin):
    x1, x2 = jnp.split(x, 2, axis=-1)
    c = cos[:, None, :].astype(x.dtype)
    s = sin[:, None, :].astype(x.dtype)
    return jnp.concatenate([x1 * c - x2 * s, x2 * c + x1 * s], axis=-1)


def mla_mixer(c_q, c_kv, k_pe, q_a_g, w_q_b, kv_a_g, w_kv_b, q_g, k_g, out_g, cos, sin):
    B, L, _ = c_q.shape
    q = (rms_norm(c_q, q_a_g) @ w_q_b).reshape(B, L, MLA_HEADS, QK_HEAD)
    kv = (rms_norm(c_kv, kv_a_g) @ w_kv_b).reshape(B, L, MLA_HEADS, QK_NOPE + V_HEAD)
    k_nope, v = kv[..., :QK_NOPE], kv[..., QK_NOPE:]
    k_pe_h = jnp.broadcast_to(k_pe[:, :, None, :], (B, L, MLA_HEADS, QK_ROPE))
    k = jnp.concatenate([k_nope, k_pe_h], axis=-1)
    q = rms_norm(q, q_g)
    k = rms_norm(k, k_g)
    q = jnp.concatenate([q[..., :QK_NOPE], apply_rope(q[..., QK_NOPE:], cos, sin)], axis=-1)
    k = jnp.concatenate([k[..., :QK_NOPE], apply_rope(k[..., QK_NOPE:], cos, sin)], axis=-1)
    scale = QK_HEAD ** -0.5
    bounds = [0] + [N_META + BLOCK * j for j in range((L - N_META) // BLOCK + 1)]
    outs = []
    for start, end in zip(bounds[:-1], bounds[1:]):
        qb, kb, vb = q[:, start:end], k[:, :end], v[:, :end]
        s = jnp.einsum('bqhd,bkhd->bhqk', qb, kb).astype(jnp.float32) * scale
        causal = jnp.arange(start, end)[:, None] >= jnp.arange(end)[None, :]
        s = jnp.where(causal[None, None], s, NEG_INF)
        p = jax.nn.softmax(s, axis=-1).astype(vb.dtype)
        outs.append(jnp.einsum('bhqk,bkhd->bqhd', p, vb))
    o = jnp.concatenate(outs, axis=1)
    o = rms_norm(o, out_g.reshape(MLA_HEADS, V_HEAD))
    return o.reshape(B, L, MLA_WIDTH)


def retention_mixer(rq, rk, rv, rg, norm_g, norm_b, cos, sin):
    B, L, _ = rq.shape
    dt = rq.dtype
    q = apply_rope(rq.reshape(B, L, RET_HEADS, RET_HEAD), cos, sin).astype(jnp.float32)
    k = (apply_rope(rk.reshape(B, L, RET_HEADS, RET_HEAD), cos, sin) * RET_HEAD ** -0.5).astype(jnp.float32)
    v = rv.reshape(B, L, RET_HEADS, RET_HEAD).astype(jnp.float32)
    pad = BLOCK - N_META
    padw = ((0, 0), (pad, 0), (0, 0), (0, 0))
    q, k, v = (jnp.pad(t, padw) for t in (q, k, v))
    Lp = L + pad
    n_chunks = Lp // BLOCK

    def to_chunks(t):
        return t.reshape(B, n_chunks, BLOCK, RET_HEADS, RET_HEAD).transpose(1, 0, 3, 2, 4)

    qc, kc, vc = to_chunks(q), to_chunks(k), to_chunks(v)
    gamma = 1.0 - 2.0 ** (-5.0 - jnp.arange(RET_HEADS, dtype=jnp.float32))
    log_g = jnp.log(gamma)
    idx = jnp.arange(BLOCK, dtype=jnp.float32)
    diff = idx[:, None] - idx[None, :]
    decay = jnp.where(diff >= 0, jnp.exp(jnp.maximum(diff, 0.0)[None] * log_g[:, None, None]), 0.0)
    xi = jnp.exp((idx + 1.0)[None, :] * log_g[:, None])
    zeta = jnp.exp((BLOCK - 1.0 - idx)[None, :] * log_g[:, None])
    chunk_decay = jnp.exp(BLOCK * log_g)

    def step(state, inp):
        qb, kb, vb = inp
        s = jnp.einsum('bhnd,bhmd->bhnm', qb, kb) * decay[None]
        inner = jnp.einsum('bhnm,bhmd->bhnd', s, vb)
        cross = jnp.einsum('bhnd,bhde->bhne', qb, state) * xi[None, :, :, None]
        new_state = state * chunk_decay[None, :, None, None] + jnp.einsum(
            'bhmd,bhme->bhde', kb * zeta[None, :, :, None], vb)
        return new_state, inner + cross

    state0 = jnp.zeros((B, RET_HEADS, RET_HEAD, RET_HEAD), jnp.float32)
    _, o = lax.scan(step, state0, (qc, kc, vc))
    o = o.transpose(1, 0, 3, 2, 4).reshape(B, Lp, RET_HEADS, RET_HEAD)[:, pad:]
    mu = jnp.mean(o, axis=-1, keepdims=True)
    var = jnp.mean(jnp.square(o - mu), axis=-1, keepdims=True)
    o = ((o - mu) * lax.rsqrt(var + EPS)).reshape(B, L, RET_WIDTH)
    o = o * norm_g.astype(jnp.float32) + norm_b.astype(jnp.float32)
    return (jax.nn.silu(rg.astype(jnp.float32)) * o).astype(dt)


def setup_inputs(seed: int = 0) -> dict:
    key = jax.random.key(seed)
    ks = jax.random.split(key, 20)

    def w(k, shape, fan_in):
        return jax.random.normal(k, shape, jnp.float32) * fan_in ** -0.5

    def gain(k, shape):
        return 1.0 + 0.02 * jax.random.normal(k, shape, jnp.float32)

    return {
        "x": jax.random.normal(ks[0], (BATCH, SEQ, D_MODEL), jnp.float32),
        "meta_tokens": jax.random.normal(ks[1], (N_META, D_MODEL), jnp.float32),
        "attn_norm_g": gain(ks[2], (DEPTH, D_MODEL)),
        "w_in": w(ks[3], (DEPTH, D_MODEL, N_IN), D_MODEL),
        "q_a_norm_g": gain(ks[4], (DEPTH, Q_LORA)),
        "w_q_b": w(ks[5], (DEPTH, Q_LORA, MLA_HEADS * QK_HEAD), Q_LORA),
        "kv_a_norm_g": gain(ks[6], (DEPTH, KV_LORA)),
        "w_kv_b": w(ks[7], (DEPTH, KV_LORA, MLA_HEADS * (QK_NOPE + V_HEAD)), KV_LORA),
        "q_norm_g": gain(ks[8], (DEPTH, QK_HEAD)),
        "k_norm_g": gain(ks[9], (DEPTH, QK_HEAD)),
        "mla_out_norm_g": gain(ks[10], (DEPTH, MLA_WIDTH)),
        "ret_norm_g": gain(ks[11], (DEPTH, RET_WIDTH)),
        "ret_norm_b": 0.02 * jax.random.normal(ks[12], (DEPTH, RET_WIDTH), jnp.float32),
        "w_out": w(ks[13], (DEPTH, MIX_WIDTH, D_MODEL), MIX_WIDTH),
        "ffn_norm_g": gain(ks[14], (DEPTH, D_MODEL)),
        "w_gate_up": w(ks[15], (DEPTH, D_MODEL, 2 * D_FF), D_MODEL),
        "w_down": w(ks[16], (DEPTH, D_FF, D_MODEL), D_FF),
    }


def reference(x, meta_tokens, attn_norm_g, w_in, q_a_norm_g, w_q_b, kv_a_norm_g, w_kv_b,
              q_norm_g, k_norm_g, mla_out_norm_g, ret_norm_g, ret_norm_b, w_out,
              ffn_norm_g, w_gate_up, w_down):
    B = x.shape[0]
    meta = jnp.broadcast_to(meta_tokens[None].astype(x.dtype), (B, N_META, D_MODEL))
    h_res = jnp.concatenate([meta, x], axis=1)
    L = h_res.shape[1]
    cos_m, sin_m = rope_tables(L, QK_ROPE)
    cos_r, sin_r = rope_tables(L, RET_HEAD)
    split_idx = [int(v) for v in np.cumsum(IN_SIZES)[:-1]]
    for l in range(DEPTH):
        h = rms_norm(h_res, attn_norm_g[l])
        z = h @ w_in[l]
        c_q, c_kv, k_pe, rq, rk, rv, rg = jnp.split(z, split_idx, axis=-1)
        y_mla = mla_mixer(c_q, c_kv, k_pe, q_a_norm_g[l], w_q_b[l], kv_a_norm_g[l], w_kv_b[l],
                          q_norm_g[l], k_norm_g[l], mla_out_norm_g[l], cos_m, sin_m)
        y_ret = retention_mixer(rq, rk, rv, rg, ret_norm_g[l], ret_norm_b[l], cos_r, sin_r)
        y = jnp.concatenate([y_mla, y_ret], axis=-1) @ w_out[l]
        h_res = h_res + y
        hf = rms_norm(h_res, ffn_norm_g[l])
        gate, up = jnp.split(hf @ w_gate_up[l], 2, axis=-1)
        h_res = h_res + (jax.nn.silu(gate) * up) @ w_down[l]
    return h_res[:, N_META:]
```

```cpp
#include <hip/hip_runtime.h>
#include <hip/hip_cooperative_groups.h>
#include <cstdio>
#include <cstdint>
namespace cg = cooperative_groups;

typedef unsigned short bf16_t;
typedef short bf16x8 __attribute__((ext_vector_type(8)));
typedef short s16x4 __attribute__((ext_vector_type(4)));
typedef float f32x4 __attribute__((ext_vector_type(4)));
typedef float f32x16 __attribute__((ext_vector_type(16)));
typedef unsigned u32x4 __attribute__((ext_vector_type(4)));
typedef unsigned u32x2 __attribute__((ext_vector_type(2)));
typedef __bf16 bf16v2 __attribute__((ext_vector_type(2)));
typedef __attribute__((address_space(3))) s16x4 lds_s16x4;
#define DI __device__ __forceinline__

constexpr int MREAL = 16384, MV = 16512, MP = 16640;
constexpr int NINP = 2816, DFF = 2816;
constexpr float EPSN = 1e-6f;
constexpr float LOG2E = 1.4426950408889634f;

constexpr size_t SZ_WIN = (size_t)2816 * 1024 * 2, SZ_WQB = (size_t)1024 * 256 * 2, SZ_WKVB = (size_t)1024 * 256 * 2, SZ_WOUT = (size_t)1024 * 1024 * 2;
constexpr size_t O_WIN = 0, O_WQB = O_WIN + SZ_WIN, O_WKVB = O_WQB + SZ_WQB, O_WOUT = O_WKVB + SZ_WKVB, O_HX = O_WOUT + SZ_WOUT;
constexpr size_t O_Z = O_HX + (size_t)256 * 1024 * 4;
constexpr size_t SZ_Z = (size_t)MP * 2816 * 2;
constexpr size_t O_KVRAW = O_Z, O_KST = O_KVRAW + (size_t)MP * 1024 * 2, O_QRAW = O_KST + (size_t)544 * 16384 * 2, O_Y = O_QRAW;
constexpr size_t O_HB = O_Z + SZ_Z, O_QF = O_HB;
constexpr size_t O_R = O_HB + (size_t)MP * 1024 * 2;
constexpr size_t SZ_R512 = (size_t)MP * 512 * 2;
constexpr size_t O_CN = O_R, O_RQ = O_CN + SZ_R512, O_RK = O_RQ + SZ_R512, O_RV = O_RK + SZ_R512, O_RG = O_RV + SZ_R512,
                 O_KPE = O_RG + SZ_R512, O_KSS = O_KPE + (size_t)MP * 64 * 2, O_KF = O_KSS + (size_t)MP * 4;
constexpr size_t O_WGU = O_R, O_WDN = O_WGU + (size_t)5632 * 1024 * 2;
constexpr size_t O_BAR = O_KF + (size_t)MP * 768 * 2;
constexpr size_t O_RSS = O_BAR + 16384, O_RSSM = O_RSS + (size_t)MREAL * 16 * 4;
constexpr size_t O_CQSS = O_RSSM + (size_t)128 * 64 * 4, O_CKVSS = O_CQSS + (size_t)MV * 8 * 4, O_KSS2 = O_CKVSS + (size_t)MV * 8 * 4;
constexpr size_t WS_NEED = O_KSS2 + (size_t)MV * 2 * 4;
static_assert(O_Y + (size_t)MP * 1024 * 2 <= O_Z + SZ_Z, "y fits");
static_assert(O_WDN + (size_t)1024 * 2816 * 2 <= O_KPE, "ffn weights fit");
static_assert(WS_NEED <= (size_t)256 * 1024 * 1024, "ws fits");

struct Params {
  const float* x; const float* meta; const float* attn_g; const float* w_in; const float* qa_g; const float* w_qb;
  const float* kva_g; const float* w_kvb; const float* q_g; const float* k_g; const float* mo_g; const float* rn_g; const float* rn_b;
  const float* w_out; const float* ffn_g; const float* w_gu; const float* w_dn;
  float* out; unsigned char* ws;
};

DI float bf2f(bf16_t b) { return __uint_as_float(((unsigned)b) << 16); }
DI unsigned pack2(float a, float b) { bf16v2 v = {(__bf16)a, (__bf16)b}; return __builtin_bit_cast(unsigned, v); }
DI bf16_t f2bf(float a) { return (bf16_t)(pack2(a, 0.f) & 0xffffu); }
DI float wave_sum(float v) {
#pragma unroll
  for (int o = 32; o; o >>= 1) v += __shfl_xor(v, o);
  return v;
}
DI int opq(int v) { asm volatile("" : "+v"(v)); return v; }
DI float fexp2(float x) { return __builtin_amdgcn_exp2f(x); }
DI f32x16 mfma32(bf16x8 a, bf16x8 b, f32x16 c) { return __builtin_amdgcn_mfma_f32_32x32x16_bf16(a, b, c, 0, 0, 0); }
DI int crow(int i, int h) { return (i & 3) + 8 * (i >> 2) + 4 * h; }
DI bf16x8 tr8(const unsigned char* p0, const unsigned char* p1) {
  s16x4 a = __builtin_amdgcn_ds_read_tr16_b64_v4i16((lds_s16x4*)p0);
  s16x4 b = __builtin_amdgcn_ds_read_tr16_b64_v4i16((lds_s16x4*)p1);
  return __builtin_shufflevector(a, b, 0, 1, 2, 3, 4, 5, 6, 7);
}
DI bf16x8 pack8(const f32x16& x, int s) {
  u32x4 p;
  p[0] = pack2(x[8 * s + 0], x[8 * s + 1]); p[1] = pack2(x[8 * s + 2], x[8 * s + 3]);
  p[2] = pack2(x[8 * s + 4], x[8 * s + 5]); p[3] = pack2(x[8 * s + 6], x[8 * s + 7]);
  return __builtin_bit_cast(bf16x8, p);
}
DI int tok_pos(int r) { return r < MREAL ? 16 + (r & 2047) : ((r - MREAL) & 15); }
DI int ret_row(int b, int c, int idx) { return c > 0 ? b * 2048 + (c - 1) * 128 + idx : (idx >= 112 ? MREAL + 16 * b + idx - 112 : -1); }

constexpr int BM = 256, BK = 64, HALF = 128, HT = HALF * BK, NXCD = 8, WGM = 8;
DI int lds_byte(int r, int c) { int st = (r >> 4) * 2 + (c >> 5), rr = r & 15, cc = c & 31, ob = rr * 64 + cc * 2; return st * 1024 + (ob ^ (((ob >> 9) & 1) << 5)); }
DI void stage_rc(int b, int& R, int& C) { int st = b / 1024, sb = b % 1024, swz = sb ^ (((sb >> 9) & 1) << 5); R = (st >> 1) * 16 + swz / 64; C = (st & 1) * 32 + (swz % 64) / 2; }

DI bool tile_order(int L, int nM, int nN, int& pm, int& pn) {
  const int nwg = nM * nN; if (L >= nwg) return false;
  int wgid = L; { const int q = nwg / NXCD, r = nwg % NXCD, xcd = wgid % NXCD, off = wgid / NXCD; wgid = (xcd < r ? xcd * (q + 1) : r * (q + 1) + (xcd - r) * q) + off; }
  const int nig = WGM * nN, gid = wgid / nig, fm = gid * WGM, gsz = (nM - fm) < WGM ? (nM - fm) : WGM;
  pm = fm + ((wgid % nig) % gsz); pn = (wgid % nig) / gsz; return true;
}

DI void st4(bf16_t* p, const f32x4 v) { u32x2 w; w[0] = pack2(v[0], v[1]); w[1] = pack2(v[2], v[3]); *(u32x2*)p = w; }
DI void st8(bf16_t* p, const f32x4 v0, const f32x4 v1) { u32x4 w; w[0] = pack2(v0[0], v0[1]); w[1] = pack2(v0[2], v0[3]); w[2] = pack2(v1[0], v1[1]); w[3] = pack2(v1[2], v1[3]); *(u32x4*)p = w; }
DI float row_rs16(const float* __restrict__ rss, int row) {
  const f32x4* q = (const f32x4*)(rss + (size_t)row * 16); const f32x4 a = q[0], b = q[1], c = q[2], d = q[3];
  return rsqrtf(((a[0] + a[1] + a[2] + a[3]) + (b[0] + b[1] + b[2] + b[3]) + (c[0] + c[1] + c[2] + c[3]) + (d[0] + d[1] + d[2] + d[3])) * (1.f / 1024.f) + EPSN);
}
DI float row_rs64(const float* __restrict__ rssm, int mrow) {
  const f32x4* q = (const f32x4*)(rssm + (size_t)mrow * 64); float s = 0.f;
#pragma unroll
  for (int i = 0; i < 16; ++i) { const f32x4 a = q[i]; s += (a[0] + a[1]) + (a[2] + a[3]); }
  return rsqrtf(s * (1.f / 1024.f) + EPSN);
}
struct EpiBf16 { bf16_t* O; int ldc; const float* rss; int nsl; float invw; DI const float* scale_src() const { return rss; } DI int scale_n() const { return nsl; } DI float scale_inv() const { return invw; }
  DI void operator()(const f32x4 (&acc)[2][2][4][2], int pm, int pn, int wr, int wc, int fr, int fq, const float* rsl) const {
#pragma unroll
    for (int ai = 0; ai < 2; ++ai)
#pragma unroll
      for (int m = 0; m < 4; ++m) { const size_t row = (size_t)pm * 256 + ai * 128 + wr * 64 + m * 16 + fr;
        const float rs = rss ? rsl[ai * 128 + wr * 64 + m * 16 + fr] : 1.f;
#pragma unroll
        for (int bj = 0; bj < 2; ++bj)
#pragma unroll
          for (int n = 0; n < 2; ++n) { const int col = pn * 256 + bj * 128 + wc * 32 + n * 16 + fq * 4; const f32x4 a = acc[ai][bj][m][n] * rs;
            u32x2 w; w[0] = pack2(a[0], a[1]); w[1] = pack2(a[2], a[3]); *(u32x2*)(O + row * ldc + col) = w; } }
  }
};
struct EpiRes { const float* resf; const bf16_t* resb; float* outf; bf16_t* hb; float* rss; DI const float* scale_src() const { return nullptr; } DI int scale_n() const { return 16; } DI float scale_inv() const { return 1.f; }
  DI void operator()(const f32x4 (&acc)[2][2][4][2], int pm, int pn, int wr, int wc, int fr, int fq, const float* rsl) const {
#pragma unroll
    for (int ai = 0; ai < 2; ++ai) {
      f32x4 t[4][2][2];
#pragma unroll
      for (int m = 0; m < 4; ++m) { const size_t off = (size_t)(pm * 256 + ai * 128 + wr * 64 + m * 16 + fr) * 1024 + pn * 256 + wc * 32 + fq * 8;
#pragma unroll
        for (int bj = 0; bj < 2; ++bj) {
          if (resf) { t[m][bj][0] = *(const f32x4*)(resf + off + bj * 128); t[m][bj][1] = *(const f32x4*)(resf + off + bj * 128 + 4); }
          else { const u32x4 raw = *(const u32x4*)(resb + off + bj * 128);
            t[m][bj][0] = (f32x4){__uint_as_float(raw[0] << 16), __uint_as_float(raw[0] & 0xffff0000u), __uint_as_float(raw[1] << 16), __uint_as_float(raw[1] & 0xffff0000u)};
            t[m][bj][1] = (f32x4){__uint_as_float(raw[2] << 16), __uint_as_float(raw[2] & 0xffff0000u), __uint_as_float(raw[3] << 16), __uint_as_float(raw[3] & 0xffff0000u)}; } } }
#pragma unroll
      for (int m = 0; m < 4; ++m) { const int row = pm * 256 + ai * 128 + wr * 64 + m * 16 + fr; float s = 0.f;
#pragma unroll
        for (int bj = 0; bj < 2; ++bj) { const int col = pn * 256 + bj * 128 + wc * 32 + fq * 8;
          const f32x4 v0 = t[m][bj][0] + acc[ai][bj][m][0], v1 = t[m][bj][1] + acc[ai][bj][m][1];
          if (outf) { *(f32x4*)(outf + (size_t)row * 1024 + col) = v0; *(f32x4*)(outf + (size_t)row * 1024 + col + 4) = v1; }
          else { u32x4 w; w[0] = pack2(v0[0], v0[1]); w[1] = pack2(v0[2], v0[3]); w[2] = pack2(v1[0], v1[1]); w[3] = pack2(v1[2], v1[3]); *(u32x4*)(hb + (size_t)row * 1024 + col) = w;
            s += ((v0[0] * v0[0] + v0[1] * v0[1]) + (v0[2] * v0[2] + v0[3] * v0[3])) + ((v1[0] * v1[0] + v1[1] * v1[1]) + (v1[2] * v1[2] + v1[3] * v1[3])); } }
        if (!outf) { s += __shfl_xor(s, 16); s += __shfl_xor(s, 32);
          if (fq == 0) rss[(size_t)row * 16 + pn * 4 + wc] = s; } }
    }
  }
};
struct EpiSwiglu { bf16_t* O; const float* rss; DI const float* scale_src() const { return rss; } DI int scale_n() const { return 16; } DI float scale_inv() const { return 1.f / 1024.f; }
  DI void operator()(const f32x4 (&acc)[2][2][4][2], int pm, int pn, int wr, int wc, int fr, int fq, const float* rsl) const {
#pragma unroll
    for (int ai = 0; ai < 2; ++ai)
#pragma unroll
      for (int m = 0; m < 4; ++m) { const size_t row = (size_t)pm * 256 + ai * 128 + wr * 64 + m * 16 + fr;
        const float rs = rsl[ai * 128 + wr * 64 + m * 16 + fr];
        float o[8];
#pragma unroll
        for (int n = 0; n < 2; ++n) { const f32x4 g = acc[ai][0][m][n] * rs, u = acc[ai][1][m][n] * rs;
#pragma unroll
          for (int j = 0; j < 4; ++j) o[4 * n + j] = g[j] * __builtin_amdgcn_rcpf(1.f + __expf(-g[j])) * u[j]; }
        u32x4 w; w[0] = pack2(o[0], o[1]); w[1] = pack2(o[2], o[3]); w[2] = pack2(o[4], o[5]); w[3] = pack2(o[6], o[7]);
        *(u32x4*)(O + row * DFF + pn * 128 + wc * 32 + 8 * fq) = w; }
  }
};

struct G1Out { bf16_t *cn, *rq, *rk, *rv, *rg, *kpe; float *cqss, *ckvss, *kss2; const float* k_g; };
DI void g1_emit(const G1Out& o, int row, int pn, int bj, int wc, int fq, const f32x4 v0, const f32x4 v1) {
  const int cb = bj * 128 + wc * 32 + fq * 8;
  if (pn < 2) {
    st8(o.cn + (size_t)row * 512 + pn * 256 + cb, v0, v1);
    float s = ((v0[0] * v0[0] + v0[1] * v0[1]) + (v0[2] * v0[2] + v0[3] * v0[3])) + ((v1[0] * v1[0] + v1[1] * v1[1]) + (v1[2] * v1[2] + v1[3] * v1[3]));
    s += __shfl_xor(s, 16); s += __shfl_xor(s, 32);
    if (fq == 0) (pn == 0 ? o.cqss : o.ckvss)[(size_t)row * 8 + bj * 4 + wc] = s;
  } else if (pn < 6) {
    const float pos = (float)tok_pos(row), sc = pn >= 4 ? 0.08838834764831845f : 1.f;
    f32x4 o0, o1;
#pragma unroll
    for (int j = 0; j < 4; ++j) { const float inv = fexp2(-(float)(2 * (wc * 16 + fq * 4 + j)) * (13.287712379549449f / 128.f)); float sn, cs; __sincosf(pos * inv, &sn, &cs);
      o0[j] = (v0[j] * cs - v1[j] * sn) * sc; o1[j] = (v1[j] * cs + v0[j] * sn) * sc; }
    st8((pn < 4 ? o.rq : o.rk) + (size_t)row * 512 + ((pn & 1) * 2 + bj) * 128 + wc * 32 + fq * 8, o0, o1);
  } else if (pn < 10) {
    st8((pn < 8 ? o.rv : o.rg) + (size_t)row * 512 + (pn & 1) * 256 + cb, v0, v1);
  } else if (bj == 0 && wc < 2) {
    float s = ((v0[0] * v0[0] + v0[1] * v0[1]) + (v0[2] * v0[2] + v0[3] * v0[3])) + ((v1[0] * v1[0] + v1[1] * v1[1]) + (v1[2] * v1[2] + v1[3] * v1[3]));
    s += __shfl_xor(s, 16); s += __shfl_xor(s, 32);
    if (fq == 0) o.kss2[(size_t)row * 2 + wc] = s;
    const float pos = (float)tok_pos(row); const int i0 = wc * 16 + fq * 4;
    const f32x4 g1 = *(const f32x4*)(o.k_g + 128 + i0), g2 = *(const f32x4*)(o.k_g + 160 + i0);
    f32x4 o0, o1;
#pragma unroll
    for (int j = 0; j < 4; ++j) { const float inv = fexp2(-(float)(2 * (i0 + j)) * (13.287712379549449f / 64.f)); float sn, cs; __sincosf(pos * inv, &sn, &cs);
      const float a1 = v0[j] * g1[j], a2 = v1[j] * g2[j]; o0[j] = a1 * cs - a2 * sn; o1[j] = a2 * cs + a1 * sn; }
    st8(o.kpe + (size_t)row * 64 + wc * 32 + fq * 8, o0, o1);
  }
}
struct EpiG1 { G1Out o; const float* rss; DI const float* scale_src() const { return rss; } DI int scale_n() const { return 16; } DI float scale_inv() const { return 1.f / 1024.f; }
  DI void operator()(const f32x4 (&acc)[2][2][4][2], int pm, int pn, int wr, int wc, int fr, int fq, const float* rsl) const {
#pragma unroll
    for (int ai = 0; ai < 2; ++ai)
#pragma unroll
      for (int m = 0; m < 4; ++m) { const int row = pm * 256 + ai * 128 + wr * 64 + m * 16 + fr; const float rs = rsl[ai * 128 + wr * 64 + m * 16 + fr];
#pragma unroll
        for (int bj = 0; bj < 2; ++bj) g1_emit(o, row, pn, bj, wc, fq, acc[ai][bj][m][0] * rs, acc[ai][bj][m][1] * rs); }
  }
};

struct EpiQ { bf16_t* qf; const float* cqss; const float* q_g; DI const float* scale_src() const { return cqss; } DI int scale_n() const { return 8; } DI float scale_inv() const { return 1.f / 256.f; }
  DI void operator()(const f32x4 (&acc)[2][2][4][2], int pm, int pn, int wr, int wc, int fr, int fq, const float* rsl) const {
    extern __shared__ __attribute__((aligned(16))) unsigned char smem[];
    float* part = (float*)smem;
#pragma unroll
    for (int ai = 0; ai < 2; ++ai)
#pragma unroll
      for (int m = 0; m < 4; ++m) { const int rl = ai * 128 + wr * 64 + m * 16 + fr; const float rs = rsl[rl]; float s = 0.f;
#pragma unroll
        for (int bj = 0; bj < 2; ++bj)
#pragma unroll
          for (int n = 0; n < 2; ++n) { const f32x4 v = acc[ai][bj][m][n] * rs; s += (v[0] * v[0] + v[1] * v[1]) + (v[2] * v[2] + v[3] * v[3]); }
        s += __shfl_xor(s, 16); s += __shfl_xor(s, 32);
        if (fq == 0) part[rl * 4 + wc] = s; }
    __syncthreads();
    const float SCQ = 0.07216878364870322f * LOG2E;
#pragma unroll
    for (int ai = 0; ai < 2; ++ai)
#pragma unroll
      for (int m = 0; m < 4; ++m) { const int rl = ai * 128 + wr * 64 + m * 16 + fr; const int row = pm * 256 + rl;
        const f32x4 pt = *(const f32x4*)(part + rl * 4);
        const float sc = rsl[rl] * rsqrtf(((pt[0] + pt[1]) + (pt[2] + pt[3])) * (1.f / 192.f) + EPSN) * SCQ;
        bf16_t* qo = qf + ((size_t)row * 4 + pn) * 192;
        { const int d = wc * 32 + fq * 8; const f32x4 ga = *(const f32x4*)(q_g + d), gb = *(const f32x4*)(q_g + d + 4); st8(qo + d, acc[ai][0][m][0] * sc * ga, acc[ai][0][m][1] * sc * gb); }
        if (wc < 2) { const int i0 = wc * 16 + fq * 4; const float pos = (float)tok_pos(row);
          const f32x4 g1 = *(const f32x4*)(q_g + 128 + i0), g2 = *(const f32x4*)(q_g + 160 + i0);
          const f32x4 a1 = acc[ai][1][m][0] * sc * g1, a2 = acc[ai][1][m][1] * sc * g2; f32x4 o0, o1;
#pragma unroll
          for (int j = 0; j < 4; ++j) { const float inv = fexp2(-(float)(2 * (i0 + j)) * (13.287712379549449f / 64.f)); float sn, cs; __sincosf(pos * inv, &sn, &cs);
            o0[j] = a1[j] * cs - a2[j] * sn; o1[j] = a2[j] * cs + a1[j] * sn; }
          st8(qo + 128 + wc * 32 + fq * 8, o0, o1); } }
  }
};
struct EpiKV { bf16_t* kf; bf16_t* kvraw; const bf16_t* kpe; const float* kss2; const float* ckvss; const float* k_g;
  DI const float* scale_src() const { return ckvss; } DI int scale_n() const { return 8; } DI float scale_inv() const { return 1.f / 256.f; }
  DI void operator()(const f32x4 (&acc)[2][2][4][2], int pm, int pn, int wr, int wc, int fr, int fq, const float* rsl) const {
    extern __shared__ __attribute__((aligned(16))) unsigned char smem[];
    float* part = (float*)smem;
#pragma unroll
    for (int ai = 0; ai < 2; ++ai)
#pragma unroll
      for (int m = 0; m < 4; ++m) { const int rl = ai * 128 + wr * 64 + m * 16 + fr; const float rs = rsl[rl]; float s = 0.f;
#pragma unroll
        for (int n = 0; n < 2; ++n) { const f32x4 v = acc[ai][0][m][n] * rs; s += (v[0] * v[0] + v[1] * v[1]) + (v[2] * v[2] + v[3] * v[3]); }
        s += __shfl_xor(s, 16); s += __shfl_xor(s, 32);
        if (fq == 0) part[rl * 4 + wc] = s; }
    __syncthreads();
#pragma unroll
    for (int ai = 0; ai < 2; ++ai)
#pragma unroll
      for (int m = 0; m < 4; ++m) { const int rl = ai * 128 + wr * 64 + m * 16 + fr; const int row = pm * 256 + rl; const float rs = rsl[rl];
        const f32x4 pt = *(const f32x4*)(part + rl * 4);
        const float rk_ = rsqrtf((((pt[0] + pt[1]) + (pt[2] + pt[3])) + kss2[(size_t)row * 2] + kss2[(size_t)row * 2 + 1]) * (1.f / 192.f) + EPSN);
        bf16_t* ko = kf + ((size_t)row * 4 + pn) * 192;
        { const int d = wc * 32 + fq * 8; const f32x4 ga = *(const f32x4*)(k_g + d), gb = *(const f32x4*)(k_g + d + 4);
          st8(ko + d, acc[ai][0][m][0] * (rs * rk_) * ga, acc[ai][0][m][1] * (rs * rk_) * gb);
          st8(kvraw + (size_t)row * 1024 + pn * 256 + 128 + d, acc[ai][1][m][0] * rs, acc[ai][1][m][1] * rs); }
        { const int c = wc * 16 + fq * 4; const u32x2 raw = *(const u32x2*)(kpe + (size_t)row * 64 + c);
          f32x4 kp = {__uint_as_float(raw[0] << 16), __uint_as_float(raw[0] & 0xffff0000u), __uint_as_float(raw[1] << 16), __uint_as_float(raw[1] & 0xffff0000u)};
          st4(ko + 128 + c, kp * rk_); } }
  }
};

template <class Epi, bool PERMB = false>
DI void gemm_tile(const bf16_t* __restrict__ A, int lda, const bf16_t* __restrict__ Bt, int K, int pm, int pn, const Epi& epi) {
  const int TX = opq((int)threadIdx.x);
  extern __shared__ __attribute__((aligned(16))) unsigned char smem[];
  bf16_t* shm = (bf16_t*)smem;
#define SA(b, h) (shm + ((b) * 2 + (h)) * HT)
#define SB(b, h) (shm + (4 + (b) * 2 + (h)) * HT)
#define STAGE(P, BASE, LD, br, kt, VO) do { const char* _ub = (const char*)((BASE) + (long)(br) * (LD) + (long)(kt) * BK); \
    __builtin_amdgcn_global_load_lds((const unsigned*)(_ub + VO[0]), (unsigned*)((char*)(P) + sb0), 16, 0, 0); \
    __builtin_amdgcn_global_load_lds((const unsigned*)(_ub + VO[1]), (unsigned*)((char*)(P) + sb0 + 8192), 16, 0, 0); } while (0)
#define LDA(dst, b, h) _Pragma("unroll") for (int m = 0; m < 4; ++m) _Pragma("unroll") for (int k = 0; k < 2; ++k) \
    dst[m][k] = *reinterpret_cast<const bf16x8*>((char*)SA(b, h) + aoff + m * 2048 + k * 1024)
#define LDB(dst, b, h) _Pragma("unroll") for (int n = 0; n < 2; ++n) _Pragma("unroll") for (int k = 0; k < 2; ++k) \
    dst[n][k] = *reinterpret_cast<const bf16x8*>((char*)SB(b, h) + boff + n * 2048 + k * 1024)
#define MMA(ai, bj, At_, Bt_) do { __builtin_amdgcn_s_setprio(1); \
    _Pragma("unroll") for (int m = 0; m < 4; ++m) _Pragma("unroll") for (int n = 0; n < 2; ++n) _Pragma("unroll") for (int k = 0; k < 2; ++k) \
      acc[ai][bj][m][n] = __builtin_amdgcn_mfma_f32_16x16x32_bf16(Bt_[n][k], At_[m][k], acc[ai][bj][m][n], 0, 0, 0); \
    __builtin_amdgcn_s_setprio(0); } while (0)
#define WAIT_V(n) asm volatile("s_waitcnt vmcnt(" #n ")" ::: "memory")
#define WAIT_L(n) asm volatile("s_waitcnt lgkmcnt(" #n ")" ::: "memory")
#define BAR __builtin_amdgcn_s_barrier()
#define SCHED __builtin_amdgcn_sched_barrier(0)
  const int brow = pm * BM, bcol = pn * BM;
  const int wid = TX >> 6, lane = TX & 63, wr = wid >> 2, wc = wid & 3, fr = lane & 15, fq = lane >> 4;
  const int sb0 = TX * 16;
  unsigned voA[2], voB[2];
#pragma unroll
  for (int i = 0; i < 2; ++i) { int R, C; stage_rc(sb0 + i * 8192, R, C); voA[i] = (unsigned)(R * lda + C) * 2u;
    const int rho = R & 31, Rb = PERMB ? ((R & ~31) + 8 * ((rho & 15) >> 2) + 4 * (rho >> 4) + (rho & 3)) : R;
    voB[i] = (unsigned)(Rb * K + C) * 2u; }
  const int aoff = lds_byte(wr * 64 + fr, fq * 8), boff = lds_byte(wc * 32 + fr, fq * 8);
  f32x4 acc[2][2][4][2] = {};
  bf16x8 At[4][2], B0[2][2], B1[2][2];
  const int nt = K / BK;
  float* rsl = (float*)(smem + 131072 + 256);
  const float* rsrc = epi.scale_src();
  f32x4 q0 = {0.f, 0.f, 0.f, 0.f}, q1 = q0, q2 = q0, q3 = q0;
  const int rsn = epi.scale_n();
  if (rsrc && TX < 256) { const f32x4* q = (const f32x4*)(rsrc + (size_t)(brow + TX) * rsn); q0 = q[0]; q1 = q[1]; if (rsn == 16) { q2 = q[2]; q3 = q[3]; } }
  STAGE(SB(0, 0), Bt, K, bcol, 0, voB); STAGE(SA(0, 0), A, lda, brow, 0, voA);
  STAGE(SB(0, 1), Bt, K, bcol + HALF, 0, voB); STAGE(SA(0, 1), A, lda, brow + HALF, 0, voA);
  if (wr == 1) BAR;
  WAIT_V(4); BAR;
  if (rsrc && TX < 256) rsl[TX] = rsqrtf(((q0[0] + q0[1] + q0[2] + q0[3]) + (q1[0] + q1[1] + q1[2] + q1[3]) + (q2[0] + q2[1] + q2[2] + q2[3]) + (q3[0] + q3[1] + q3[2] + q3[3])) * epi.scale_inv() + EPSN);
  STAGE(SB(1, 0), Bt, K, bcol, 1, voB); STAGE(SA(1, 0), A, lda, brow, 1, voA); STAGE(SB(1, 1), Bt, K, bcol + HALF, 1, voB);
  WAIT_V(6); BAR;
  for (int t = 0; t < nt - 2; t += 2) {
    LDB(B0, 0, 0); SCHED; LDA(At, 0, 0); STAGE(SA(1, 1), A, lda, brow + HALF, t + 1, voA);
    WAIT_L(8); BAR; WAIT_L(0); MMA(0, 0, At, B0); BAR; SCHED;
    LDB(B1, 0, 1); STAGE(SB(0, 0), Bt, K, bcol, t + 2, voB);
    BAR; WAIT_L(0); MMA(0, 1, At, B1); BAR;
    LDA(At, 0, 1); STAGE(SA(0, 0), A, lda, brow, t + 2, voA);
    BAR; WAIT_L(0); MMA(1, 0, At, B0); BAR; SCHED;
    STAGE(SB(0, 1), Bt, K, bcol + HALF, t + 2, voB);
    WAIT_V(6); BAR; MMA(1, 1, At, B1); BAR;
    LDB(B0, 1, 0); SCHED; LDA(At, 1, 0); STAGE(SA(0, 1), A, lda, brow + HALF, t + 2, voA);
    WAIT_L(8); BAR; WAIT_L(0); MMA(0, 0, At, B0); BAR; SCHED;
    LDB(B1, 1, 1); STAGE(SB(1, 0), Bt, K, bcol, t + 3, voB);
    BAR; WAIT_L(0); MMA(0, 1, At, B1); BAR;
    LDA(At, 1, 1); STAGE(SA(1, 0), A, lda, brow, t + 3, voA);
    BAR; WAIT_L(0); MMA(1, 0, At, B0); BAR; SCHED;
    STAGE(SB(1, 1), Bt, K, bcol + HALF, t + 3, voB);
    WAIT_V(6); BAR; MMA(1, 1, At, B1); BAR;
  }
  { LDB(B0, 0, 0); LDA(At, 0, 0); STAGE(SA(1, 1), A, lda, brow + HALF, nt - 1, voA);
    BAR; WAIT_L(0); MMA(0, 0, At, B0); BAR;
    LDB(B1, 0, 1); BAR; WAIT_L(0); MMA(0, 1, At, B1); BAR;
    LDA(At, 0, 1); WAIT_V(4); BAR; WAIT_L(0); MMA(1, 0, At, B0); MMA(1, 1, At, B1); BAR; }
  { LDB(B0, 1, 0); LDA(At, 1, 0); WAIT_V(2); BAR; WAIT_L(0); MMA(0, 0, At, B0); BAR;
    LDB(B1, 1, 1); WAIT_V(0); BAR; WAIT_L(0); MMA(0, 1, At, B1); BAR;
    LDA(At, 1, 1); BAR; WAIT_L(0); MMA(1, 0, At, B0); MMA(1, 1, At, B1); BAR; }
  if (wr == 0) BAR;
  epi(acc, pm, pn, wr, wc, fr, fq, rsl);
  __syncthreads();
#undef SA
#undef SB
#undef STAGE
#undef LDA
#undef LDB
#undef MMA
}

template <class Epi, bool PERMB = false>
DI void gemm_phase(const bf16_t* A, int lda, const bf16_t* Bt, int K, int nM, int nN, const Epi& epi) {
  for (int i = 0;; ++i) { int pm, pn; if (!tile_order(i * (int)gridDim.x + (int)blockIdx.x, nM, nN, pm, pn)) break; gemm_tile<Epi, PERMB>(A, lda, Bt, K, pm, pn, epi); }
}

DI float row_rsN(const float* __restrict__ p, int n4, float invw) {
  float s = 0.f;
  for (int i = 0; i < n4; ++i) { const f32x4 a = ((const f32x4*)p)[i]; s += (a[0] + a[1]) + (a[2] + a[3]); }
  return rsqrtf(s * invw + EPSN);
}
template <int MODE>
DI void skinny_task(const bf16_t* __restrict__ A, int lda, const bf16_t* __restrict__ Bt, int K, int t, bf16_t* O, int ldc, float* hx, float* sl, int sl_stride, int sl_n4, float sl_inv, const G1Out* g1o) {
  const int TX = opq((int)threadIdx.x);
  const int lane = TX & 63, w = TX >> 6, fr = lane & 15, fq = lane >> 4;
  const int row = MREAL + 16 * w + fr;
  const int c0 = 16 * t;
  const int n0 = MODE == 2 ? ((c0 >> 7) * 256 + (c0 & 127)) : (MODE == 3 ? ((t >> 3) * 256 + ((t >> 2) & 1) * 128 + (t & 3) * 32) : c0);
  const bf16_t* ap = A + (size_t)row * lda + 8 * fq;
  const bf16_t* bp0 = Bt + (size_t)(n0 + (MODE == 3 ? 8 * (fr >> 2) + (fr & 3) : fr)) * K + 8 * fq;
  const bf16_t* bp1 = bp0 + (size_t)(MODE == 3 ? 4 : 128) * K;
  constexpr bool TWO = MODE >= 2;
  f32x4 acc0 = {0.f, 0.f, 0.f, 0.f}, acc1 = {0.f, 0.f, 0.f, 0.f};
  constexpr int NS = 8, KB_ = NS * 32;
  bf16x8 a[NS], b0[NS], b1[NS], a2[NS], c0v[NS], c1v[NS];
#define SK_LOAD(A_, B0_, B1_, k_) _Pragma("unroll") for (int s = 0; s < NS; ++s) { A_[s] = *(const bf16x8*)(ap + (k_) + 32 * s); B0_[s] = *(const bf16x8*)(bp0 + (k_) + 32 * s); if (TWO) B1_[s] = *(const bf16x8*)(bp1 + (k_) + 32 * s); }
#define SK_MMA(A_, B0_, B1_) _Pragma("unroll") for (int s = 0; s < NS; ++s) { acc0 = __builtin_amdgcn_mfma_f32_16x16x32_bf16(B0_[s], A_[s], acc0, 0, 0, 0); if (TWO) acc1 = __builtin_amdgcn_mfma_f32_16x16x32_bf16(B1_[s], A_[s], acc1, 0, 0, 0); }
  SK_LOAD(a, b0, b1, 0);
  for (int k = 0; k < K; k += 2 * KB_) {
    if (k + KB_ < K) SK_LOAD(a2, c0v, c1v, k + KB_);
    SK_MMA(a, b0, b1);
    if (k + KB_ < K) { if (k + 2 * KB_ < K) SK_LOAD(a, b0, b1, k + 2 * KB_); SK_MMA(a2, c0v, c1v); }
  }
#undef SK_LOAD
#undef SK_MMA
  const int col = c0 + 4 * fq;
  const float rs = (MODE != 1 && sl) ? row_rsN(sl + (size_t)(sl_stride == 64 ? row - MREAL : row) * sl_stride, sl_n4, sl_inv) : 1.f;
  if (MODE == 0) { st4(O + (size_t)row * ldc + col, acc0 * rs); }
  else if (MODE == 1) { float* rp = hx + (size_t)(row - MREAL) * 1024 + col; f32x4 v = *(f32x4*)rp; v += acc0; *(f32x4*)rp = v;
    st4(O + (size_t)row * 1024 + col, v);
    float s = (v[0] * v[0] + v[1] * v[1]) + (v[2] * v[2] + v[3] * v[3]); s += __shfl_xor(s, 16); s += __shfl_xor(s, 32);
    if (fq == 0) sl[(size_t)(row - MREAL) * 64 + t] = s; }
  else if (MODE == 2) { f32x4 o;
#pragma unroll
    for (int j = 0; j < 4; ++j) { const float g = acc0[j] * rs; o[j] = g * __builtin_amdgcn_rcpf(1.f + __expf(-g)) * (acc1[j] * rs); }
    st4(O + (size_t)row * DFF + col, o); }
  else { g1_emit(*g1o, row, t >> 3, (t >> 2) & 1, t & 3, fq, acc0 * rs, acc1 * rs); }
}
template <int MODE>
DI void skinny_phase(const bf16_t* A, int lda, const bf16_t* Bt, int K, int ntask, bf16_t* O, int ldc, float* hx, float* sl, int sl_stride, int sl_n4, float sl_inv, const G1Out* g1o) {
  for (int t = (int)gridDim.x - 1 - (int)blockIdx.x; t < ntask; t += (int)gridDim.x) skinny_task<MODE>(A, lda, Bt, K, t, O, ldc, hx, sl, sl_stride, sl_n4, sl_inv, g1o);
}

template <int NSTEPS>
DI void skinny_res_task(const bf16_t* __restrict__ A, int lda, const bf16_t* __restrict__ Bt, int K, int task, bf16_t* hbp, float* hxp, float* rssmp) {
  extern __shared__ __attribute__((aligned(16))) unsigned char smem[];
  const int TX = opq((int)threadIdx.x);
  const int lane = TX & 63, w = TX >> 6, fr = lane & 15, fq = lane >> 4;
  const int rgp = task & 7, cg = task >> 3;
  const int row = MREAL + 16 * rgp + fr;
  const int k0 = w * (NSTEPS * 32);
  const bf16_t* ap = A + (size_t)row * lda + k0 + 8 * fq;
  const bf16_t* bp0 = Bt + (size_t)(16 * cg + fr) * K + k0 + 8 * fq;
  const bf16_t* bp1 = bp0 + (size_t)512 * K;
  bf16x8 a[NSTEPS], b0[NSTEPS], b1[NSTEPS];
#pragma unroll
  for (int s = 0; s < NSTEPS; ++s) { a[s] = *(const bf16x8*)(ap + 32 * s); b0[s] = *(const bf16x8*)(bp0 + 32 * s); b1[s] = *(const bf16x8*)(bp1 + 32 * s); }
  f32x4 acc0 = {0.f, 0.f, 0.f, 0.f}, acc1 = {0.f, 0.f, 0.f, 0.f};
#pragma unroll
  for (int s = 0; s < NSTEPS; ++s) { acc0 = __builtin_amdgcn_mfma_f32_16x16x32_bf16(b0[s], a[s], acc0, 0, 0, 0); acc1 = __builtin_amdgcn_mfma_f32_16x16x32_bf16(b1[s], a[s], acc1, 0, 0, 0); }
  f32x4* part = (f32x4*)smem;
  part[w * 64 + lane] = acc0; part[512 + w * 64 + lane] = acc1;
  __syncthreads();
  if (w < 2) {
    f32x4 v = part[w * 512 + lane];
#pragma unroll
    for (int j = 1; j < 8; ++j) v += part[w * 512 + j * 64 + lane];
    const int cgw = cg + 32 * w, col = 16 * cgw + 4 * fq;
    float* rp = hxp + (size_t)(row - MREAL) * 1024 + col; v += *(const f32x4*)rp; *(f32x4*)rp = v;
    st4(hbp + (size_t)row * 1024 + col, v);
    float s = (v[0] * v[0] + v[1] * v[1]) + (v[2] * v[2] + v[3] * v[3]); s += __shfl_xor(s, 16); s += __shfl_xor(s, 32);
    if (fq == 0) rssmp[(size_t)(row - MREAL) * 64 + cgw] = s;
  }
  __syncthreads();
}

DI void conv_w(const float* __restrict__ src, int K, int Nsrc, bf16_t* __restrict__ dst, int Nd, int mode, const float* __restrict__ g, int blk, int nblk) {
  extern __shared__ __attribute__((aligned(16))) unsigned char smem[];
  const int TX = opq((int)threadIdx.x);
  if (blk < 0) return;
  const int lane = TX & 63, w = TX >> 6;
  const int ntn = Nd >> 6, ntiles = ntn * (K >> 7);
  for (int t = blk; t < ntiles; t += nblk) {
    const int n0 = (t % ntn) << 6, k0 = (t / ntn) << 7;
    const int n = n0 + lane;
    int sc = n;
    if (mode == 1) { const int tn = n >> 8, hf = (n >> 7) & 1, i = n & 127; sc = hf * DFF + tn * 128 + i; }
    else if (mode == 2) { const int tn = n >> 8, c = n & 255;
      if (tn < 2) sc = n;
      else if (tn < 6) { const int cc = c & 127; sc = (tn < 4 ? 576 : 1088) + (((tn & 1) * 2 + (c >> 7)) * 128) + ((cc >> 2) & 1) * 64 + (cc >> 5) * 16 + ((cc >> 3) & 3) * 4 + (cc & 3); }
      else if (tn < 8) sc = 1600 + (tn - 6) * 256 + c;
      else if (tn < 10) sc = 2112 + (tn - 8) * 256 + c;
      else sc = c < 64 ? 512 + ((c >> 2) & 1) * 32 + (c >> 5) * 16 + ((c >> 3) & 3) * 4 + (c & 3) : -1; }
    else if (mode == 3) { const int hd = n >> 8, c = n & 255;
      if (c < 128) sc = hd * 192 + c;
      else if (c < 192) { const int pp = c - 128; sc = hd * 192 + 128 + ((pp >> 2) & 1) * 32 + (pp >> 5) * 16 + ((pp >> 3) & 3) * 4 + (pp & 3); }
      else sc = -1; }
    else if (n >= Nsrc) sc = -1;
    u32x4 o0 = {0u, 0u, 0u, 0u}, o1 = {0u, 0u, 0u, 0u};
    if (sc >= 0) { const int kb = k0 + 8 * w; const float* p = src + (size_t)kb * Nsrc + sc;
      float v[16];
#pragma unroll
      for (int j = 0; j < 8; ++j) { v[j] = p[(size_t)j * Nsrc]; v[8 + j] = p[(size_t)(64 + j) * Nsrc]; }
      if (g) {
#pragma unroll
        for (int j = 0; j < 8; ++j) { v[j] *= g[kb + j]; v[8 + j] *= g[kb + 64 + j]; } }
      o0[0] = pack2(v[0], v[1]); o0[1] = pack2(v[2], v[3]); o0[2] = pack2(v[4], v[5]); o0[3] = pack2(v[6], v[7]);
      o1[0] = pack2(v[8], v[9]); o1[1] = pack2(v[10], v[11]); o1[2] = pack2(v[12], v[13]); o1[3] = pack2(v[14], v[15]); }
    *(u32x4*)(smem + lane * 272 + w * 16) = o0; *(u32x4*)(smem + lane * 272 + 128 + w * 16) = o1;
    __syncthreads();
#pragma unroll
    for (int i = 0; i < 2; ++i) { const int idx = TX + 512 * i, rn = idx >> 4, ch = idx & 15;
      *(u32x4*)(dst + (size_t)(n0 + rn) * K + k0 + ch * 8) = *(const u32x4*)(smem + rn * 272 + ch * 16); }
    __syncthreads();
  }
}

DI void phase_init(const Params& p, bf16_t* hb, float* hx, float* rss, float* rssm) {
  const int TX = opq((int)threadIdx.x);
  const int lane = TX & 63, gw = blockIdx.x * 8 + (TX >> 6), nw = gridDim.x * 8;
  for (int r = gw; r < MV; r += nw) {
    f32x4 v[4];
    float* drow = r < MREAL ? p.out + (size_t)r * 1024 : hx + (size_t)(r - MREAL) * 1024;
    const float* src = r < MREAL ? p.x + (size_t)r * 1024 : p.meta + (size_t)((r - MREAL) & 15) * 1024;
    float ss = 0.f;
#pragma unroll
    for (int i = 0; i < 2; ++i) { const int c0 = i * 512 + lane * 8;
      v[2 * i] = *(const f32x4*)(src + c0); v[2 * i + 1] = *(const f32x4*)(src + c0 + 4);
      if (r >= MREAL) { *(f32x4*)(drow + c0) = v[2 * i]; *(f32x4*)(drow + c0 + 4) = v[2 * i + 1]; }
      st8(hb + (size_t)r * 1024 + c0, v[2 * i], v[2 * i + 1]);
#pragma unroll
      for (int q = 0; q < 2; ++q) { const f32x4 t = v[2 * i + q]; ss += (t[0] * t[0] + t[1] * t[1]) + (t[2] * t[2] + t[3] * t[3]); } }
    ss = wave_sum(ss);
    if (r < MREAL) { if (lane < 16) rss[(size_t)r * 16 + lane] = lane == 0 ? ss : 0.f; }
    else rssm[(size_t)(r - MREAL) * 64 + lane] = lane == 0 ? ss : 0.f;
  }
}

DI void phase_r3(const bf16_t* __restrict__ qraw, const bf16_t* __restrict__ kvraw, const bf16_t* __restrict__ kpe, const float* __restrict__ kss,
                 const float* __restrict__ q_g, const float* __restrict__ k_g, bf16_t* qf, bf16_t* kf) {
  const int TX = opq((int)threadIdx.x);
  const int lane = TX & 63, gw = blockIdx.x * 8 + (TX >> 6), nw = gridDim.x * 8;
  const float inv64 = fexp2(-(float)(2 * (lane & 31)) * (13.287712379549449f / 64.f));
  const float SCQ = 0.07216878364870322f * LOG2E;
  const int pl = (((lane & 31) >> 4) << 5) + ((((lane & 31) >> 2) & 3) << 3) + ((lane >> 5) << 2) + (lane & 3);
  const float qg0 = q_g[lane], qg1 = q_g[64 + lane], qg2 = q_g[128 + lane], kg0 = k_g[lane], kg1 = k_g[64 + lane];
  for (int it = gw; it < (MV - MREAL) * 4; it += nw) { const int r = MREAL + (it >> 2), h = it & 3;
    float sn, cs; __sincosf((float)tok_pos(r) * inv64, &sn, &cs);
    const float kssr = kss[(size_t)r * 2] + kss[(size_t)r * 2 + 1];
    const float kp = bf2f(kpe[(size_t)r * 64 + lane]);
    {
      const bf16_t* qp = qraw + (size_t)(r - MREAL) * 1024 + h * 256;
      const float v0 = bf2f(qp[lane]), v1 = bf2f(qp[64 + lane]), v2 = bf2f(qp[128 + pl]);
      const float rs = rsqrtf(wave_sum(v0 * v0 + v1 * v1 + v2 * v2) * (1.f / 192.f) + EPSN) * SCQ;
      const float t2 = v2 * rs * qg2, oth = __shfl_xor(t2, 32);
      const float o2 = lane < 32 ? t2 * cs - oth * sn : t2 * cs + oth * sn;
      bf16_t* qo = qf + ((size_t)r * 4 + h) * 192;
      qo[lane] = f2bf(v0 * rs * qg0); qo[64 + lane] = f2bf(v1 * rs * qg1); qo[128 + pl] = f2bf(o2);
      const bf16_t* kq = kvraw + (size_t)r * 1024 + h * 256;
      const float k0 = bf2f(kq[lane]), k1 = bf2f(kq[64 + lane]);
      const float rk_ = rsqrtf((wave_sum(k0 * k0 + k1 * k1) + kssr) * (1.f / 192.f) + EPSN);
      bf16_t* ko = kf + ((size_t)r * 4 + h) * 192;
      ko[lane] = f2bf(k0 * rk_ * kg0); ko[64 + lane] = f2bf(k1 * rk_ * kg1); ko[128 + lane] = f2bf(kp * rk_);
    }
  }
}

DI void phase_scan(bf16_t* kst) {
  const int TX = opq((int)threadIdx.x);
  const long gt = (long)blockIdx.x * 512 + TX, gn = (long)gridDim.x * 512;
  for (long idx = gt; idx < 32L * 8192; idx += gn) {
    const int bh = (int)(idx >> 13), ed = (int)(idx & 8191) * 2, h = bh & 3;
    const float g128 = fexp2(128.f * __log2f(1.f - fexp2(-5.f - (float)h)));
    unsigned* base = (unsigned*)(kst + (size_t)bh * 17 * 16384 + ed);
    unsigned v[17];
#pragma unroll
    for (int c = 0; c < 17; ++c) v[c] = base[(size_t)c * 8192];
    float s0 = 0.f, s1 = 0.f;
#pragma unroll
    for (int c = 0; c < 17; ++c) { const float t0 = __uint_as_float(v[c] << 16), t1 = __uint_as_float(v[c] & 0xffff0000u);
      base[(size_t)c * 8192] = pack2(s0, s1); s0 = s0 * g128 + t0; s1 = s1 * g128 + t1; }
  }
}

DI void kvc_unit(const bf16_t* __restrict__ rk, const bf16_t* __restrict__ rv, bf16_t* kst, int b, int h, int c) {
  const int TX = opq((int)threadIdx.x);
  extern __shared__ __attribute__((aligned(16))) unsigned char smem[];
  unsigned char* Vs = smem; unsigned char* Ks = smem + 40960;
  const int tid = TX, lane = tid & 63, w = tid >> 6, eb = w & 3, dh = w >> 2, r = lane & 31, hh = lane >> 5;
  const int q4 = (lane & 15) >> 2, p4 = lane & 3, blk = (lane >> 4) & 1;
  const float log2g = __log2f(1.f - fexp2(-5.f - (float)h));
#pragma unroll
  for (int i = 0; i < 4; ++i) { const int idx = tid + 512 * i, m = idx >> 4, ch = idx & 15; const int row = ret_row(b, c, m);
    u32x4 kv = {0u, 0u, 0u, 0u}, vv = {0u, 0u, 0u, 0u};
    if (row >= 0) { kv = *(const u32x4*)(rk + (size_t)row * 512 + h * 128 + ch * 8); vv = *(const u32x4*)(rv + (size_t)row * 512 + h * 128 + ch * 8); }
    const float zeta = fexp2((float)(127 - m) * log2g);
#pragma unroll
    for (int j = 0; j < 4; ++j) kv[j] = pack2(__uint_as_float(kv[j] << 16) * zeta, __uint_as_float(kv[j] & 0xffff0000u) * zeta);
    *(u32x4*)(Ks + (m * 160 + ch * 8) * 2) = kv; *(u32x4*)(Vs + (m * 160 + ch * 8) * 2) = vv; }
  __syncthreads();
  f32x16 acc[2];
#pragma unroll
  for (int i = 0; i < 16; ++i) { acc[0][i] = 0.f; acc[1][i] = 0.f; }
#pragma unroll
  for (int s = 0; s < 8; ++s) {
    const int k0 = 16 * s + 8 * hh + q4;
    const unsigned char* pa = Vs + (k0 * 160 + 32 * eb + 16 * blk + 4 * p4) * 2;
    const bf16x8 a = tr8(pa, pa + 4 * 160 * 2);
#pragma unroll
    for (int db = 0; db < 2; ++db) { const unsigned char* pb = Ks + (k0 * 160 + 64 * dh + 32 * db + 16 * blk + 4 * p4) * 2;
      const bf16x8 bb = tr8(pb, pb + 4 * 160 * 2); acc[db] = mfma32(a, bb, acc[db]); }
  }
  bf16_t* o = kst + ((size_t)((b * 4 + h) * 17 + c)) * 16384;
#pragma unroll
  for (int db = 0; db < 2; ++db)
#pragma unroll
    for (int i = 0; i < 16; ++i) o[(32 * eb + crow(i, hh)) * 128 + 64 * dh + 32 * db + r] = f2bf(acc[db][i]);
  __syncthreads();
}

DI void ret_unit(const bf16_t* __restrict__ rq, const bf16_t* __restrict__ rk, const bf16_t* __restrict__ rv, const bf16_t* __restrict__ rg,
                 const bf16_t* __restrict__ kst, bf16_t* y, const float* __restrict__ rn_g, const float* __restrict__ rn_b, int b, int h, int c) {
  const int TX = opq((int)threadIdx.x);
  extern __shared__ __attribute__((aligned(16))) unsigned char smem[];
  unsigned char* Ks = smem; unsigned char* Vs = smem + 34816; unsigned char* Ss = smem + 75776;
  float* comb = (float*)smem;
  const int tid = TX, lane = tid & 63, w = tid >> 6, nb = w & 3, grp = w >> 2, r = lane & 31, hh = lane >> 5;
  const int q4 = (lane & 15) >> 2, p4 = lane & 3, blk = (lane >> 4) & 1;
  const float log2g = __log2f(1.f - fexp2(-5.f - (float)h));
  const bf16_t* st = kst + ((size_t)((b * 4 + h) * 17 + c)) * 16384;
#pragma unroll
  for (int i = 0; i < 4; ++i) { const int idx = tid + 512 * i, m = idx >> 4, ch = idx & 15; const int row = ret_row(b, c, m);
    u32x4 kv = {0u, 0u, 0u, 0u}, vv = {0u, 0u, 0u, 0u};
    if (row >= 0) { kv = *(const u32x4*)(rk + (size_t)row * 512 + h * 128 + ch * 8); vv = *(const u32x4*)(rv + (size_t)row * 512 + h * 128 + ch * 8); }
    *(u32x4*)(Ks + (m * 136 + ch * 8) * 2) = kv; *(u32x4*)(Vs + (m * 160 + ch * 8) * 2) = vv;
    *(u32x4*)(Ss + (m * 136 + ch * 8) * 2) = *(const u32x4*)(st + m * 128 + ch * 8); }
  const int n = 32 * nb + r;
  const int qrow = ret_row(b, c, n);
  bf16x8 qfr[8];
#pragma unroll
  for (int s = 0; s < 8; ++s) { if (qrow >= 0) qfr[s] = *(const bf16x8*)(rq + (size_t)qrow * 512 + h * 128 + 16 * s + 8 * hh); else qfr[s] = (bf16x8){0, 0, 0, 0, 0, 0, 0, 0}; }
  __syncthreads();
  f32x16 acc[4];
#pragma unroll
  for (int eb = 0; eb < 4; ++eb)
#pragma unroll
    for (int i = 0; i < 16; ++i) acc[eb][i] = 0.f;
  const bool active = c > 0 || (nb == 3 && grp == 1);
  if (active) {
#pragma unroll
  for (int eb = 0; eb < 4; ++eb)
#pragma unroll
    for (int s2 = 0; s2 < 4; ++s2) { const bf16x8 a = *(const bf16x8*)(Ss + ((32 * eb + r) * 136 + 16 * (4 * grp + s2) + 8 * hh) * 2);
      const bf16x8 qv = grp ? qfr[4 + s2] : qfr[s2];
      acc[eb] = mfma32(a, qv, acc[eb]); }
  const float xi = fexp2((float)(n + 1) * log2g);
#pragma unroll
  for (int eb = 0; eb < 4; ++eb)
#pragma unroll
    for (int i = 0; i < 16; ++i) acc[eb][i] *= xi;
  bf16x8 pk[2][2];
#pragma unroll
  for (int mb = 0; mb < 2; ++mb) {
    f32x16 x;
#pragma unroll
    for (int i = 0; i < 16; ++i) x[i] = 0.f;
#pragma unroll
    for (int s = 0; s < 8; ++s) { const bf16x8 a = *(const bf16x8*)(Ks + ((64 * grp + 32 * mb + r) * 136 + 16 * s + 8 * hh) * 2); x = mfma32(a, qfr[s], x); }
#pragma unroll
    for (int i = 0; i < 16; ++i) { const int dd = n - (64 * grp + 32 * mb + crow(i, hh)); x[i] = dd >= 0 ? x[i] * fexp2((float)dd * log2g) : 0.f; }
    pk[mb][0] = pack8(x, 0); pk[mb][1] = pack8(x, 1);
  }
#pragma unroll
  for (int eb = 0; eb < 4; ++eb)
#pragma unroll
    for (int mb = 0; mb < 2; ++mb)
#pragma unroll
      for (int s2 = 0; s2 < 2; ++s2) { const int m0 = 64 * grp + 32 * mb + 16 * s2 + 4 * hh + q4;
        const unsigned char* pa = Vs + (m0 * 160 + 32 * eb + 16 * blk + 4 * p4) * 2;
        const bf16x8 a = tr8(pa, pa + 8 * 160 * 2); acc[eb] = mfma32(a, pk[mb][s2], acc[eb]); }
  }
  __syncthreads();
  float* cb = comb + (size_t)nb * 64 * 64 + lane;
  if (grp == 1) {
#pragma unroll
    for (int eb = 0; eb < 4; ++eb)
#pragma unroll
      for (int i = 0; i < 16; ++i) cb[(eb * 16 + i) * 64] = acc[eb][i];
  }
  __syncthreads();
  if (grp == 0) {
    float sm = 0.f;
#pragma unroll
    for (int eb = 0; eb < 4; ++eb)
#pragma unroll
      for (int i = 0; i < 16; ++i) { acc[eb][i] += cb[(eb * 16 + i) * 64]; sm += acc[eb][i]; }
    sm += __shfl_xor(sm, 32);
    const float mu = sm * (1.f / 128.f);
    float vs = 0.f;
#pragma unroll
    for (int eb = 0; eb < 4; ++eb)
#pragma unroll
      for (int i = 0; i < 16; ++i) { const float d = acc[eb][i] - mu; vs += d * d; }
    vs += __shfl_xor(vs, 32);
    const float rs = rsqrtf(vs * (1.f / 128.f) + EPSN);
    unsigned char* stg = (unsigned char*)(comb + (size_t)nb * 64 * 64);
    if (qrow >= 0) {
#pragma unroll
      for (int eb = 0; eb < 4; ++eb)
#pragma unroll
        for (int g4 = 0; g4 < 4; ++g4) { const int el = 32 * eb + 8 * g4 + 4 * hh, e0 = h * 128 + el;
          const f32x4 gg = *(const f32x4*)(rn_g + e0), bb = *(const f32x4*)(rn_b + e0);
          const u32x2 graw = *(const u32x2*)(rg + (size_t)qrow * 512 + e0);
          float gt[4] = {__uint_as_float(graw[0] << 16), __uint_as_float(graw[0] & 0xffff0000u), __uint_as_float(graw[1] << 16), __uint_as_float(graw[1] & 0xffff0000u)};
          float o[4];
#pragma unroll
          for (int j = 0; j < 4; ++j) { const float yn = (acc[eb][4 * g4 + j] - mu) * rs * gg[j] + bb[j]; o[j] = gt[j] * __builtin_amdgcn_rcpf(1.f + __expf(-gt[j])) * yn; }
          u32x2 wv; wv[0] = pack2(o[0], o[1]); wv[1] = pack2(o[2], o[3]);
          *(u32x2*)(stg + r * 272 + el * 2) = wv; }
    }
  }
  __syncthreads();
  if (grp == 0) {
    const unsigned char* stg = (const unsigned char*)(comb + (size_t)nb * 64 * 64);
#pragma unroll
    for (int k = 0; k < 8; ++k) { const int chunk = lane + 64 * k, rw = chunk >> 4, c16 = chunk & 15; const int orow = ret_row(b, c, 32 * nb + rw);
      if (orow >= 0) *(u32x4*)(y + (size_t)orow * 1024 + 512 + h * 128 + c16 * 8) = *(const u32x4*)(stg + rw * 272 + c16 * 16); }
  }
  __syncthreads();
}

DI void attn_unit(const bf16_t* __restrict__ qf, const bf16_t* __restrict__ kf, const bf16_t* __restrict__ kvraw, bf16_t* y, const float* __restrict__ mo_g, int b, int h, int qt) {
  const int TX = opq((int)threadIdx.x);
  extern __shared__ __attribute__((aligned(16))) unsigned char smem[];
  constexpr int KB = 25600, VB = 20480;
  float* comb = (float*)smem;
  const int tid = TX, lane = tid & 63, w = tid >> 6, qb = w & 3, grp = w >> 2, r = lane & 31, hh = lane >> 5;
#define q4 ((lane & 15) >> 2)
#define p4 (lane & 3)
#define blk ((lane >> 4) & 1)
  const int qrow0 = qt < 0 ? MREAL + 16 * b : b * 2048 + 128 * qt;
  const int ql = 32 * qb + r;
  bf16x8 qfr[12];
  { const bf16_t* qp = qf + ((size_t)(qrow0 + ql) * 4 + h) * 192 + 8 * hh;
#pragma unroll
    for (int s = 0; s < 12; ++s) qfr[s] = *(const bf16x8*)(qp + 16 * s); }
  f32x16 oacc[4];
#pragma unroll
  for (int db = 0; db < 4; ++db)
#pragma unroll
    for (int i = 0; i < 16; ++i) oacc[db][i] = 0.f;
  float mrun = -1e30f, lsum = 0.f;
  const int ntile = qt < 0 ? 1 : 2 * qt + 3;
  u32x4 kA[3], vA[2];
#define ATT_LOAD(KR, VR, ti_) do { const int row0_ = (ti_) == 0 ? MREAL + 16 * b : b * 2048 + 64 * ((ti_) - 1); \
    _Pragma("unroll") for (int i = 0; i < 3; ++i) { const int idx = tid + 512 * i, key = idx / 24, ch = idx % 24; KR[i] = ((ti_) == 0 && key >= 16) ? (u32x4){0u, 0u, 0u, 0u} : *(const u32x4*)(kf + ((size_t)(row0_ + key) * 4 + h) * 192 + ch * 8); } \
    _Pragma("unroll") for (int i = 0; i < 2; ++i) { const int idx = tid + 512 * i, key = idx >> 4, ch = idx & 15; VR[i] = ((ti_) == 0 && key >= 16) ? (u32x4){0u, 0u, 0u, 0u} : *(const u32x4*)(kvraw + (size_t)(row0_ + key) * 1024 + h * 256 + 128 + ch * 8); } } while (0)
#define ATT_WRITE(KR, VR, ti_) do { unsigned char* Kw = smem + ((ti_) & 1) * KB; unsigned char* Vw = smem + 2 * KB + ((ti_) % 3) * VB; \
    _Pragma("unroll") for (int i = 0; i < 3; ++i) { const int idx = tid + 512 * i, key = idx / 24, ch = idx % 24; *(u32x4*)(Kw + (key * 200 + ch * 8) * 2) = KR[i]; } \
    _Pragma("unroll") for (int i = 0; i < 2; ++i) { const int idx = tid + 512 * i, key = idx >> 4, ch = idx & 15; *(u32x4*)(Vw + (key * 160 + ch * 8) * 2) = VR[i]; } } while (0)
#define ATT_S(ti) do { \
    const unsigned char* Ks = smem + ((ti) & 1) * KB; \
    _Pragma("unroll") for (int i = 0; i < 16; ++i) x[i] = 0.f; \
    { const unsigned char* kp = Ks + ((32 * grp + r) * 200 + 8 * hh) * 2; \
      __builtin_amdgcn_s_setprio(1); \
      _Pragma("unroll") for (int s = 0; s < 12; ++s) { const bf16x8 a = *(const bf16x8*)(kp + 32 * s); x = mfma32(a, qfr[s], x); } \
      __builtin_amdgcn_s_setprio(0); } \
    if ((ti) == 0) { \
      _Pragma("unroll") for (int i = 0; i < 16; ++i) { const int kl = 32 * grp + crow(i, hh); if (!(kl < 16 && (qt >= 0 || kl <= ql))) x[i] = -INFINITY; } \
    } else if ((ti) - 1 >= 2 * qt) { \
      const int koff = 64 * ((ti) - 1 - 2 * qt) + 32 * grp; \
      _Pragma("unroll") for (int i = 0; i < 16; ++i) { if (koff + crow(i, hh) > ql) x[i] = -INFINITY; } \
    } } while (0)
#define ATT_SOFT() do { \
    float mx = -INFINITY; \
    _Pragma("unroll") for (int i = 0; i < 16; ++i) mx = fmaxf(mx, x[i]); \
    mx = fmaxf(mx, __shfl_xor(mx, 32)); \
    const float mn = (mx > mrun + 8.f) ? mx : mrun; \
    const float alpha = fexp2(mrun - mn); \
    const bool resc = __any(mn != mrun); \
    mrun = mn; \
    float ps = 0.f; \
    _Pragma("unroll") for (int i = 0; i < 16; ++i) { const float pv = fexp2(x[i] - mn); x[i] = pv; ps += pv; } \
    lsum = lsum * alpha + ps; \
    if (resc) { _Pragma("unroll") for (int db = 0; db < 4; ++db) _Pragma("unroll") for (int i = 0; i < 16; ++i) oacc[db][i] *= alpha; } \
    pk[0] = pack8(x, 0); pk[1] = pack8(x, 1); } while (0)
#define ATT_PV(ti) do { \
    const unsigned char* Vs = smem + 2 * KB + ((ti) % 3) * VB; \
    __builtin_amdgcn_s_setprio(1); \
    _Pragma("unroll") for (int db = 0; db < 4; ++db) _Pragma("unroll") for (int s2 = 0; s2 < 2; ++s2) { const int key0 = 32 * grp + 16 * s2 + 4 * hh + q4; \
        const unsigned char* pa = Vs + (key0 * 160 + 32 * db + 16 * blk + 4 * p4) * 2; \
        const bf16x8 a = tr8(pa, pa + 8 * 160 * 2); oacc[db] = mfma32(a, pk[s2], oacc[db]); } \
    __builtin_amdgcn_s_setprio(0); } while (0)
#define ATT_COMPUTE(ti) do { f32x16 x; if (grp == 0) { ATT_S(ti); ATT_SOFT(); ATT_PV(ti); } else { if ((ti) > 0) ATT_PV((ti) - 1); ATT_S(ti); ATT_SOFT(); } } while (0)
  bf16x8 pk[2];
  ATT_LOAD(kA, vA, 0);
  ATT_WRITE(kA, vA, 0);
  __syncthreads();
  for (int ti = 0; ti < ntile; ++ti) {
    if (ti + 1 < ntile) ATT_LOAD(kA, vA, ti + 1);
    ATT_COMPUTE(ti);
    if (ti + 1 < ntile) ATT_WRITE(kA, vA, ti + 1);
    __syncthreads();
  }
  if (grp == 1) ATT_PV(ntile - 1);
  __syncthreads();
#undef ATT_S
#undef q4
#undef p4
#undef blk
#undef ATT_SOFT
#undef ATT_PV
#undef ATT_COMPUTE
#undef ATT_LOAD
#undef ATT_WRITE
  const float lt = lsum + __shfl_xor(lsum, 32);
  float* cb = comb + (size_t)qb * 66 * 64 + lane;
  if (grp == 1) {
#pragma unroll
    for (int db = 0; db < 4; ++db)
#pragma unroll
      for (int i = 0; i < 16; ++i) cb[(db * 16 + i) * 64] = oacc[db][i];
    cb[64 * 64] = mrun; cb[65 * 64] = lt;
  }
  __syncthreads();
  if (grp == 0) {
    const float m1 = cb[64 * 64], l1 = cb[65 * 64];
    const float mt = fmaxf(mrun, m1), a0 = fexp2(mrun - mt), a1 = fexp2(m1 - mt);
    const float inv = 1.f / (lt * a0 + l1 * a1);
    float ss = 0.f;
#pragma unroll
    for (int db = 0; db < 4; ++db)
#pragma unroll
      for (int i = 0; i < 16; ++i) { const float o = (oacc[db][i] * a0 + cb[(db * 16 + i) * 64] * a1) * inv; oacc[db][i] = o; ss += o * o; }
    ss += __shfl_xor(ss, 32);
    const float rs = rsqrtf(ss * (1.f / 128.f) + EPSN);
    if (qt >= 0 || ql < 16) {
      const size_t row = (size_t)(qrow0 + ql);
#pragma unroll
      for (int db = 0; db < 4; ++db)
#pragma unroll
        for (int g4 = 0; g4 < 4; ++g4) { const int d0 = h * 128 + 32 * db + 8 * g4 + 4 * hh; const f32x4 gg = *(const f32x4*)(mo_g + d0);
          u32x2 wv; wv[0] = pack2(oacc[db][4 * g4] * rs * gg[0], oacc[db][4 * g4 + 1] * rs * gg[1]); wv[1] = pack2(oacc[db][4 * g4 + 2] * rs * gg[2], oacc[db][4 * g4 + 3] * rs * gg[3]);
          *(u32x2*)(y + row * 1024 + d0) = wv; }
    }
  }
  __syncthreads();
}

#define XB_TMO      128
#define XB_XCNT(j)  (256  + 64 * (j))
#define XB_XSUB(j)  (1280 + 64 * (j))
#define XB_XGEN(j)  (2304 + 64 * (j))
#define XB_TOP      3328
#define XB_TOPGEN   3392
#define XCD_BAR_WORDS 3456
#define XB_SPIN_CAP (1u << 18)
#define LAS __attribute__((address_space(3)))
DI unsigned xb_ld(unsigned* p)              { return __hip_atomic_load(p, __ATOMIC_RELAXED, __HIP_MEMORY_SCOPE_AGENT); }
DI unsigned xb_add(unsigned* p, unsigned v) { return __hip_atomic_fetch_add(p, v, __ATOMIC_RELAXED, __HIP_MEMORY_SCOPE_AGENT); }
DI unsigned xb_xcc_id() { return (unsigned)__builtin_amdgcn_s_getreg((3 << 11) | 20) & 0xFu; }
#define XB_SPIN(cond, bar) do { unsigned _sp = 0; while (cond) { __builtin_amdgcn_s_sleep(1); \
    if ((++_sp & 255u) == 0u) { if (xb_ld(&(bar)[XB_TMO])) break; if (_sp > XB_SPIN_CAP) { atomicAdd(&(bar)[XB_TMO], 1u); break; } } } } while (0)
struct XcdBarrier { volatile LAS unsigned* st; };
DI XcdBarrier xcd_barrier_post(unsigned* bar, volatile LAS unsigned* st) {
  XcdBarrier b; b.st = st;
  if (threadIdx.x == 0) { const unsigned x = xb_xcc_id(); st[2] = x; (void)xb_add(&bar[XB_XCNT(x)], 1u); }
  return b;
}
DI void xcd_barrier_complete(unsigned* bar, unsigned x, unsigned& nloc, unsigned& nx) {
  const unsigned G = gridDim.x * gridDim.y * gridDim.z;
  unsigned sum, cnt, mine, sp = 0u;
  for (;;) {
    sum = 0u; cnt = 0u; mine = 0u;
#pragma unroll
    for (unsigned j = 0; j < 16; ++j) { const unsigned c = xb_ld(&bar[XB_XCNT(j)]); sum += c; cnt += (c > 0u) ? 1u : 0u; mine = (j == x) ? c : mine; }
    if (sum == G) break;
    __builtin_amdgcn_s_sleep(1);
    if ((++sp & 255u) == 0u) { if (xb_ld(&bar[XB_TMO])) break; if (sp > XB_SPIN_CAP) { atomicAdd(&bar[XB_TMO], 1u); break; } }
  }
  nloc = mine > 0u ? mine : 1u; nx = cnt > 0u ? cnt : 1u;
}
DI void xcd_barrier(const XcdBarrier& b, unsigned* bar) {
  asm volatile("s_waitcnt vmcnt(0)" ::: "memory");
  __syncthreads();
  if (threadIdx.x == 0) {
    __builtin_amdgcn_s_waitcnt(0);
    unsigned nloc = b.st[0], nx = b.st[1]; const unsigned bx = b.st[2];
    if (nloc == 0u) { xcd_barrier_complete(bar, bx, nloc, nx); b.st[0] = nloc; b.st[1] = nx; }
    const unsigned old = xb_add(&bar[XB_XSUB(bx)], 1u);
    const unsigned gen = old / nloc;
    if (old + 1u == (gen + 1u) * nloc) {
      __builtin_amdgcn_fence(__ATOMIC_RELEASE, "agent");
      asm volatile("s_waitcnt vmcnt(0)" ::: "memory");
      const unsigned og = xb_add(&bar[XB_TOP], 1u);
      const unsigned tg = og / nx;
      if (og + 1u == (tg + 1u) * nx) xb_add(&bar[XB_TOPGEN], 1u);
      else XB_SPIN(xb_ld(&bar[XB_TOPGEN]) == tg, bar);
      __builtin_amdgcn_fence(__ATOMIC_ACQUIRE, "agent");
      xb_add(&bar[XB_XGEN(bx)], 1u);
      asm volatile("s_waitcnt vmcnt(0)" ::: "memory");
    } else {
      XB_SPIN(xb_ld(&bar[XB_XGEN(bx)]) == gen, bar);
      __builtin_amdgcn_fence(__ATOMIC_ACQUIRE, "agent");
      asm volatile("s_waitcnt vmcnt(0)" ::: "memory");
    }
  }
  __syncthreads();
}

__global__ void __launch_bounds__(512) fwd_megakernel(Params p) {
  cg::grid_group grid = cg::this_grid();
  unsigned zoff = 0;
#define ws (p.ws + zoff)
#define Win ((bf16_t*)(ws + O_WIN))
#define Wqb ((bf16_t*)(ws + O_WQB))
#define Wkvb ((bf16_t*)(ws + O_WKVB))
#define Wout ((bf16_t*)(ws + O_WOUT))
#define Wgu ((bf16_t*)(ws + O_WGU))
#define Wdn ((bf16_t*)(ws + O_WDN))
#define hx ((float*)(ws + O_HX))
#define z ((bf16_t*)(ws + O_Z))
#define act ((bf16_t*)(ws + O_Z))
#define kvraw ((bf16_t*)(ws + O_KVRAW))
#define kst ((bf16_t*)(ws + O_KST))
#define qraw ((bf16_t*)(ws + O_QRAW))
#define y ((bf16_t*)(ws + O_Y))
#define hb ((bf16_t*)(ws + O_HB))
#define qf ((bf16_t*)(ws + O_QF))
#define cn ((bf16_t*)(ws + O_CN))
#define rq ((bf16_t*)(ws + O_RQ))
#define rk ((bf16_t*)(ws + O_RK))
#define rv ((bf16_t*)(ws + O_RV))
#define rg ((bf16_t*)(ws + O_RG))
#define kpe ((bf16_t*)(ws + O_KPE))
#define kss ((float*)(ws + O_KSS2))
#define cqss ((float*)(ws + O_CQSS))
#define ckvss ((float*)(ws + O_CKVSS))
#define kf ((bf16_t*)(ws + O_KF))
#define rss ((float*)(ws + O_RSS))
#define rssm ((float*)(ws + O_RSSM))
#define barw ((unsigned*)(ws + O_BAR))
#define SYNC() do { xcd_barrier(xb, barw); asm volatile("" : "+s"(zoff)); } while (0)
  const int G = gridDim.x, bid = blockIdx.x;
  bf16_t* const ds = (bf16_t*)p.out;
  extern __shared__ __attribute__((aligned(16))) unsigned char smem_k[];
  volatile LAS unsigned* xst = (volatile LAS unsigned*)(smem_k + 131072);
  if (threadIdx.x < 4) xst[threadIdx.x] = 0u;
  if (p.out == nullptr) grid.sync();
  __syncthreads();
  const XcdBarrier xb = xcd_barrier_post(barw, xst);

  conv_w(p.w_in, 1024, 2624, Win, 2816, 2, p.attn_g, bid, G);
  conv_w(p.w_qb, 256, 768, Wqb, 1024, 3, p.qa_g, bid, G);
  conv_w(p.w_kvb, 256, 1024, Wkvb, 1024, 0, p.kva_g, bid, G);
  conv_w(p.w_out, 1024, 1024, Wout, 1024, 0, nullptr, bid, G);
  phase_init(p, hb, hx, rss, rssm);
  SYNC();
  for (int layer = 0; layer < 2; ++layer) {
    { const G1Out go{cn, rq, rk, rv, rg, kpe, cqss, ckvss, kss, p.k_g + layer * 192};
      gemm_phase<EpiG1, true>(layer == 0 ? hb : ds, 1024, Win, 1024, 64, 11, EpiG1{go, rss});
      skinny_phase<3>(layer == 0 ? hb : ds, 1024, Win, 1024, 88, nullptr, 0, hx, rssm, 64, 16, 1.f / 1024.f, &go); }
    SYNC();
    for (int u = bid; u < 1056; u += G) {
      if (u < 256) gemm_tile<EpiQ, true>(cn, 512, Wqb, 256, u >> 2, u & 3, EpiQ{qf, cqss, p.q_g + layer * 192});
      else if (u < 512) { const int t = u - 256; gemm_tile<EpiKV, true>(cn + 256, 512, Wkvb, 256, t >> 2, t & 3, EpiKV{kf, kvraw, kpe, kss, ckvss, p.k_g + layer * 192}); }
      else { const int t = u - 512, bh = t / 17, c = t % 17; kvc_unit(rk, rv, kst, bh >> 2, bh & 3, c); }
    }
    skinny_phase<0>(cn, 512, Wqb, 256, 64, qraw - (size_t)MREAL * 1024, 1024, hx, cqss, 8, 2, 1.f / 256.f, nullptr);
    skinny_phase<0>(cn + 256, 512, Wkvb, 256, 64, kvraw, 1024, hx, ckvss, 8, 2, 1.f / 256.f, nullptr);
    SYNC();
    phase_r3(qraw, kvraw, kpe, kss, p.q_g + layer * 192, p.k_g + layer * 192, qf, kf);
    phase_scan(kst);
    SYNC();
    for (int u = bid; u < 832; u += G) {
      if (u < 256) { const int bh = ((u & 7) << 2) | (u >> 6), xq = (u >> 3) & 7;
        attn_unit(qf, kf, kvraw, y, p.mo_g + layer * 512, bh >> 2, bh & 3, 15 - xq);
        attn_unit(qf, kf, kvraw, y, p.mo_g + layer * 512, bh >> 2, bh & 3, xq); }
      else if (u < 800) { const int t = u - 256, bh = t & 31, c = 16 - (t >> 5); ret_unit(rq, rk, rv, rg, kst, y, p.rn_g + layer * 512, p.rn_b + layer * 512, bh >> 2, bh & 3, c); }
      else { const int bh = u - 800; attn_unit(qf, kf, kvraw, y, p.mo_g + layer * 512, bh >> 2, bh & 3, -1); }
    }
    SYNC();
    conv_w(p.w_gu + (size_t)layer * 1024 * 5632, 1024, 5632, Wgu, 5632, 1, p.ffn_g + layer * 1024, bid, G);
    gemm_phase<EpiRes, true>(y, 1024, Wout, 1024, 64, 4, EpiRes{layer == 0 ? p.x : nullptr, ds, nullptr, hb, rss});
    for (int t = bid; t < 256; t += G) skinny_res_task<4>(y, 1024, Wout, 1024, t, hb, hx, rssm);
    SYNC();
    gemm_phase<EpiSwiglu, true>(hb, 1024, Wgu, 1024, 64, 22, EpiSwiglu{act, rss});
    skinny_phase<2>(hb, 1024, Wgu, 1024, 176, act, DFF, hx, rssm, 64, 16, 1.f / 1024.f, nullptr);
    conv_w(p.w_dn + (size_t)layer * 2816 * 1024, 2816, 1024, Wdn, 1024, 0, nullptr, bid - G / 2, G - G / 2);
    if (layer == 0) {
      conv_w(p.w_in + (size_t)1024 * 2624, 1024, 2624, Win, 2816, 2, p.attn_g + 1024, bid - G / 2, G - G / 2);
      conv_w(p.w_qb + (size_t)256 * 768, 256, 768, Wqb, 1024, 3, p.qa_g + 256, bid - G / 2, G - G / 2);
      conv_w(p.w_kvb + (size_t)256 * 1024, 256, 1024, Wkvb, 1024, 0, p.kva_g + 256, bid - G / 2, G - G / 2);
      conv_w(p.w_out + (size_t)1024 * 1024, 1024, 1024, Wout, 1024, 0, nullptr, bid - G / 2, G - G / 2);
    }
    SYNC();
    gemm_phase<EpiRes, true>(act, DFF, Wdn, DFF, 64, 4, EpiRes{nullptr, hb, layer == 1 ? p.out : nullptr, layer == 0 ? ds : hb, rss});
    if (layer == 0) for (int t = bid; t < 256; t += G) skinny_res_task<11>(act, DFF, Wdn, DFF, t, ds, hx, rssm);
    if (layer == 0) SYNC();
  }
}

#undef Win
#undef Wqb
#undef Wkvb
#undef Wout
#undef Wgu
#undef Wdn
#undef hx
#undef z
#undef act
#undef kvraw
#undef kst
#undef qraw
#undef y
#undef hb
#undef qf
#undef cn
#undef rq
#undef rk
#undef rv
#undef rg
#undef kpe
#undef kss
#undef kf
#undef rss
#undef rssm
#undef barw
#undef SYNC
#undef ws
extern "C" void kernel_launch(void* const* d_in, const int* in_sizes, int n_in, void* d_out, int out_size, void* d_ws, size_t ws_size, hipStream_t stream) {
  constexpr size_t kDynLds = 131072 + 256 + 1024;
  static int grid_blocks = 0;
  if (!grid_blocks) {
    int dev = 0, cus = 0, per_cu = 0;
    hipGetDevice(&dev);
    hipDeviceGetAttribute(&cus, hipDeviceAttributeMultiprocessorCount, dev);
    hipFuncSetAttribute((const void*)fwd_megakernel, hipFuncAttributeMaxDynamicSharedMemorySize, (int)kDynLds);
    hipOccupancyMaxActiveBlocksPerMultiprocessor(&per_cu, fwd_megakernel, 512, kDynLds);
    if (per_cu < 1) per_cu = 1;
    grid_blocks = cus * per_cu;
  }
  Params p{};
  p.x = (const float*)d_in[0]; p.meta = (const float*)d_in[1]; p.attn_g = (const float*)d_in[2]; p.w_in = (const float*)d_in[3];
  p.qa_g = (const float*)d_in[4]; p.w_qb = (const float*)d_in[5]; p.kva_g = (const float*)d_in[6]; p.w_kvb = (const float*)d_in[7];
  p.q_g = (const float*)d_in[8]; p.k_g = (const float*)d_in[9]; p.mo_g = (const float*)d_in[10]; p.rn_g = (const float*)d_in[11]; p.rn_b = (const float*)d_in[12];
  p.w_out = (const float*)d_in[13]; p.ffn_g = (const float*)d_in[14]; p.w_gu = (const float*)d_in[15]; p.w_dn = (const float*)d_in[16];
  p.out = (float*)d_out; p.ws = (unsigned char*)d_ws;
  if (ws_size < WS_NEED) fprintf(stderr, "workspace too small: %zu < %zu\n", ws_size, (size_t)WS_NEED);
  hipMemsetAsync((unsigned char*)d_ws + O_BAR, 0, XCD_BAR_WORDS * sizeof(unsigned), stream);
  void* args[] = {&p};
  hipError_t e = hipLaunchCooperativeKernel((const void*)fwd_megakernel, dim3(grid_blocks), dim3(512), args, kDynLds, stream);
  if (e != hipSuccess) fprintf(stderr, "cooperative launch failed: %s (grid %d)\n", hipGetErrorString(e), grid_blocks);
}
```

```cpp
#include <hip/hip_runtime.h>
#include <hip/hip_cooperative_groups.h>
#include <cstdio>
#include <cstdint>
namespace cg = cooperative_groups;

typedef unsigned short bf16_t;
typedef short bf16x8 __attribute__((ext_vector_type(8)));
typedef short s16x4 __attribute__((ext_vector_type(4)));
typedef float f32x4 __attribute__((ext_vector_type(4)));
typedef float f32x16 __attribute__((ext_vector_type(16)));
typedef unsigned u32x4 __attribute__((ext_vector_type(4)));
typedef unsigned u32x2 __attribute__((ext_vector_type(2)));
typedef __bf16 bf16v2 __attribute__((ext_vector_type(2)));
typedef __attribute__((address_space(3))) s16x4 lds_s16x4;
#define DI __device__ __forceinline__

constexpr int MREAL = 16384, MV = 16512, MP = 16640;
constexpr int NINP = 2816, DFF = 2816;
constexpr float EPSN = 1e-6f;
constexpr float LOG2E = 1.4426950408889634f;

constexpr size_t SZ_WIN = (size_t)2816 * 1024 * 2, SZ_WQB = (size_t)1024 * 256 * 2, SZ_WKVB = (size_t)1024 * 256 * 2, SZ_WOUT = (size_t)1024 * 1024 * 2;
constexpr size_t O_WIN = 0, O_WQB = O_WIN + SZ_WIN, O_WKVB = O_WQB + SZ_WQB, O_WOUT = O_WKVB + SZ_WKVB, O_HX = O_WOUT + SZ_WOUT;
constexpr size_t O_Z = O_HX + (size_t)256 * 1024 * 4;
constexpr size_t SZ_Z = (size_t)MP * 2816 * 2;
constexpr size_t O_KVRAW = O_Z, O_KST = O_KVRAW + (size_t)MP * 1024 * 2, O_QRAW = O_KST + (size_t)544 * 16384 * 2, O_Y = O_QRAW;
constexpr size_t O_HB = O_Z + SZ_Z, O_QF = O_HB;
constexpr size_t O_R = O_HB + (size_t)MP * 1024 * 2;
constexpr size_t SZ_R512 = (size_t)MP * 512 * 2;
constexpr size_t O_CN = O_R, O_RQ = O_CN + SZ_R512, O_RK = O_RQ + SZ_R512, O_RV = O_RK + SZ_R512, O_RG = O_RV + SZ_R512,
                 O_KPE = O_RG + SZ_R512, O_KSS = O_KPE + (size_t)MP * 64 * 2, O_KF = O_KSS + (size_t)MP * 4;
constexpr size_t O_WGU = O_R, O_WDN = O_WGU + (size_t)5632 * 1024 * 2;
constexpr size_t O_BAR = O_KF + (size_t)MP * 768 * 2;
constexpr size_t O_RSS = O_BAR + 16384, O_RSSM = O_RSS + (size_t)MREAL * 16 * 4;
constexpr size_t O_CQSS = O_RSSM + (size_t)128 * 64 * 4, O_CKVSS = O_CQSS + (size_t)MV * 8 * 4, O_KSS2 = O_CKVSS + (size_t)MV * 8 * 4;
constexpr size_t WS_NEED = O_KSS2 + (size_t)MV * 2 * 4;
static_assert(O_Y + (size_t)MP * 1024 * 2 <= O_Z + SZ_Z, "y fits");
static_assert(O_WDN + (size_t)1024 * 2816 * 2 <= O_KPE, "ffn weights fit");
static_assert(WS_NEED <= (size_t)256 * 1024 * 1024, "ws fits");

struct Params {
  const float* x; const float* meta; const float* attn_g; const float* w_in; const float* qa_g; const float* w_qb;
  const float* kva_g; const float* w_kvb; const float* q_g; const float* k_g; const float* mo_g; const float* rn_g; const float* rn_b;
  const float* w_out; const float* ffn_g; const float* w_gu; const float* w_dn;
  float* out; unsigned char* ws;
};

DI float bf2f(bf16_t b) { return __uint_as_float(((unsigned)b) << 16); }
DI unsigned pack2(float a, float b) { bf16v2 v = {(__bf16)a, (__bf16)b}; return __builtin_bit_cast(unsigned, v); }
DI bf16_t f2bf(float a) { return (bf16_t)(pack2(a, 0.f) & 0xffffu); }
DI float wave_sum(float v) {
#pragma unroll
  for (int o = 32; o; o >>= 1) v += __shfl_xor(v, o);
  return v;
}
DI int opq(int v) { asm volatile("" : "+v"(v)); return v; }
DI float fexp2(float x) { return __builtin_amdgcn_exp2f(x); }
DI f32x16 mfma32(bf16x8 a, bf16x8 b, f32x16 c) { return __builtin_amdgcn_mfma_f32_32x32x16_bf16(a, b, c, 0, 0, 0); }
DI int crow(int i, int h) { return (i & 3) + 8 * (i >> 2) + 4 * h; }
DI bf16x8 tr8(const unsigned char* p0, const unsigned char* p1) {
  s16x4 a = __builtin_amdgcn_ds_read_tr16_b64_v4i16((lds_s16x4*)p0);
  s16x4 b = __builtin_amdgcn_ds_read_tr16_b64_v4i16((lds_s16x4*)p1);
  return __builtin_shufflevector(a, b, 0, 1, 2, 3, 4, 5, 6, 7);
}
DI bf16x8 pack8(const f32x16& x, int s) {
  u32x4 p;
  p[0] = pack2(x[8 * s + 0], x[8 * s + 1]); p[1] = pack2(x[8 * s + 2], x[8 * s + 3]);
  p[2] = pack2(x[8 * s + 4], x[8 * s + 5]); p[3] = pack2(x[8 * s + 6], x[8 * s + 7]);
  return __builtin_bit_cast(bf16x8, p);
}
DI int tok_pos(int r) { return r < MREAL ? 16 + (r & 2047) : ((r - MREAL) & 15); }
DI int ret_row(int b, int c, int idx) { return c > 0 ? b * 2048 + (c - 1) * 128 + idx : (idx >= 112 ? MREAL + 16 * b + idx - 112 : -1); }

constexpr int BM = 256, BK = 64, HALF = 128, HT = HALF * BK, NXCD = 8, WGM = 8;
DI int lds_byte(int r, int c) { int st = (r >> 4) * 2 + (c >> 5), rr = r & 15, cc = c & 31, ob = rr * 64 + cc * 2; return st * 1024 + (ob ^ (((ob >> 9) & 1) << 5)); }
DI void stage_rc(int b, int& R, int& C) { int st = b / 1024, sb = b % 1024, swz = sb ^ (((sb >> 9) & 1) << 5); R = (st >> 1) * 16 + swz / 64; C = (st & 1) * 32 + (swz % 64) / 2; }

DI bool tile_order(int L, int nM, int nN, int& pm, int& pn) {
  const int nwg = nM * nN; if (L >= nwg) return false;
  int wgid = L; { const int q = nwg / NXCD, r = nwg % NXCD, xcd = wgid % NXCD, off = wgid / NXCD; wgid = (xcd < r ? xcd * (q + 1) : r * (q + 1) + (xcd - r) * q) + off; }
  const int nig = WGM * nN, gid = wgid / nig, fm = gid * WGM, gsz = (nM - fm) < WGM ? (nM - fm) : WGM;
  pm = fm + ((wgid % nig) % gsz); pn = (wgid % nig) / gsz; return true;
}

DI void st4(bf16_t* p, const f32x4 v) { u32x2 w; w[0] = pack2(v[0], v[1]); w[1] = pack2(v[2], v[3]); *(u32x2*)p = w; }
DI void st8(bf16_t* p, const f32x4 v0, const f32x4 v1) { u32x4 w; w[0] = pack2(v0[0], v0[1]); w[1] = pack2(v0[2], v0[3]); w[2] = pack2(v1[0], v1[1]); w[3] = pack2(v1[2], v1[3]); *(u32x4*)p = w; }
DI float row_rs16(const float* __restrict__ rss, int row) {
  const f32x4* q = (const f32x4*)(rss + (size_t)row * 16); const f32x4 a = q[0], b = q[1], c = q[2], d = q[3];
  return rsqrtf(((a[0] + a[1] + a[2] + a[3]) + (b[0] + b[1] + b[2] + b[3]) + (c[0] + c[1] + c[2] + c[3]) + (d[0] + d[1] + d[2] + d[3])) * (1.f / 1024.f) + EPSN);
}
DI float row_rs64(const float* __restrict__ rssm, int mrow) {
  const f32x4* q = (const f32x4*)(rssm + (size_t)mrow * 64); float s = 0.f;
#pragma unroll
  for (int i = 0; i < 16; ++i) { const f32x4 a = q[i]; s += (a[0] + a[1]) + (a[2] + a[3]); }
  return rsqrtf(s * (1.f / 1024.f) + EPSN);
}
struct EpiBf16 { bf16_t* O; int ldc; const float* rss; int nsl; float invw; DI const float* scale_src() const { return rss; } DI int scale_n() const { return nsl; } DI float scale_inv() const { return invw; }
  DI void operator()(const f32x4 (&acc)[2][2][4][2], int pm, int pn, int wr, int wc, int fr, int fq, const float* rsl) const {
#pragma unroll
    for (int ai = 0; ai < 2; ++ai)
#pragma unroll
      for (int m = 0; m < 4; ++m) { const size_t row = (size_t)pm * 256 + ai * 128 + wr * 64 + m * 16 + fr;
        const float rs = rss ? rsl[ai * 128 + wr * 64 + m * 16 + fr] : 1.f;
#pragma unroll
        for (int bj = 0; bj < 2; ++bj)
#pragma unroll
          for (int n = 0; n < 2; ++n) { const int col = pn * 256 + bj * 128 + wc * 32 + n * 16 + fq * 4; const f32x4 a = acc[ai][bj][m][n] * rs;
            u32x2 w; w[0] = pack2(a[0], a[1]); w[1] = pack2(a[2], a[3]); *(u32x2*)(O + row * ldc + col) = w; } }
  }
};
struct EpiRes { const float* resf; const bf16_t* resb; float* outf; bf16_t* hb; float* rss; DI const float* scale_src() const { return nullptr; } DI int scale_n() const { return 16; } DI float scale_inv() const { return 1.f; }
  DI void operator()(const f32x4 (&acc)[2][2][4][2], int pm, int pn, int wr, int wc, int fr, int fq, const float* rsl) const {
#pragma unroll
    for (int ai = 0; ai < 2; ++ai) {
      f32x4 t[4][2][2];
#pragma unroll
      for (int m = 0; m < 4; ++m) { const size_t off = (size_t)(pm * 256 + ai * 128 + wr * 64 + m * 16 + fr) * 1024 + pn * 256 + wc * 32 + fq * 8;
#pragma unroll
        for (int bj = 0; bj < 2; ++bj) {
          if (resf) { t[m][bj][0] = *(const f32x4*)(resf + off + bj * 128); t[m][bj][1] = *(const f32x4*)(resf + off + bj * 128 + 4); }
          else { const u32x4 raw = *(const u32x4*)(resb + off + bj * 128);
            t[m][bj][0] = (f32x4){__uint_as_float(raw[0] << 16), __uint_as_float(raw[0] & 0xffff0000u), __uint_as_float(raw[1] << 16), __uint_as_float(raw[1] & 0xffff0000u)};
            t[m][bj][1] = (f32x4){__uint_as_float(raw[2] << 16), __uint_as_float(raw[2] & 0xffff0000u), __uint_as_float(raw[3] << 16), __uint_as_float(raw[3] & 0xffff0000u)}; } } }
#pragma unroll
      for (int m = 0; m < 4; ++m) { const int row = pm * 256 + ai * 128 + wr * 64 + m * 16 + fr; float s = 0.f;
#pragma unroll
        for (int bj = 0; bj < 2; ++bj) { const int col = pn * 256 + bj * 128 + wc * 32 + fq * 8;
          const f32x4 v0 = t[m][bj][0] + acc[ai][bj][m][0], v1 = t[m][bj][1] + acc[ai][bj][m][1];
          if (outf) { *(f32x4*)(outf + (size_t)row * 1024 + col) = v0; *(f32x4*)(outf + (size_t)row * 1024 + col + 4) = v1; }
          else { u32x4 w; w[0] = pack2(v0[0], v0[1]); w[1] = pack2(v0[2], v0[3]); w[2] = pack2(v1[0], v1[1]); w[3] = pack2(v1[2], v1[3]); *(u32x4*)(hb + (size_t)row * 1024 + col) = w;
            s += ((v0[0] * v0[0] + v0[1] * v0[1]) + (v0[2] * v0[2] + v0[3] * v0[3])) + ((v1[0] * v1[0] + v1[1] * v1[1]) + (v1[2] * v1[2] + v1[3] * v1[3])); } }
        if (!outf) { s += __shfl_xor(s, 16); s += __shfl_xor(s, 32);
          if (fq == 0) rss[(size_t)row * 16 + pn * 4 + wc] = s; } }
    }
  }
};
struct EpiSwiglu { bf16_t* O; const float* rss; DI const float* scale_src() const { return rss; } DI int scale_n() const { return 16; } DI float scale_inv() const { return 1.f / 1024.f; }
  DI void operator()(const f32x4 (&acc)[2][2][4][2], int pm, int pn, int wr, int wc, int fr, int fq, const float* rsl) const {
#pragma unroll
    for (int ai = 0; ai < 2; ++ai)
#pragma unroll
      for (int m = 0; m < 4; ++m) { const size_t row = (size_t)pm * 256 + ai * 128 + wr * 64 + m * 16 + fr;
        const float rs = rsl[ai * 128 + wr * 64 + m * 16 + fr];
        float o[8];
#pragma unroll
        for (int n = 0; n < 2; ++n) { const f32x4 g = acc[ai][0][m][n] * rs, u = acc[ai][1][m][n] * rs;
#pragma unroll
          for (int j = 0; j < 4; ++j) o[4 * n + j] = g[j] * __builtin_amdgcn_rcpf(1.f + __expf(-g[j])) * u[j]; }
        u32x4 w; w[0] = pack2(o[0], o[1]); w[1] = pack2(o[2], o[3]); w[2] = pack2(o[4], o[5]); w[3] = pack2(o[6], o[7]);
        *(u32x4*)(O + row * DFF + pn * 128 + wc * 32 + 8 * fq) = w; }
  }
};

struct G1Out { bf16_t *cn, *rq, *rk, *rv, *rg, *kpe; float *cqss, *ckvss, *kss2; const float* k_g; };
DI void g1_emit(const G1Out& o, int row, int pn, int bj, int wc, int fq, const f32x4 v0, const f32x4 v1) {
  const int cb = bj * 128 + wc * 32 + fq * 8;
  if (pn < 2) {
    st8(o.cn + (size_t)row * 512 + pn * 256 + cb, v0, v1);
    float s = ((v0[0] * v0[0] + v0[1] * v0[1]) + (v0[2] * v0[2] + v0[3] * v0[3])) + ((v1[0] * v1[0] + v1[1] * v1[1]) + (v1[2] * v1[2] + v1[3] * v1[3]));
    s += __shfl_xor(s, 16); s += __shfl_xor(s, 32);
    if (fq == 0) (pn == 0 ? o.cqss : o.ckvss)[(size_t)row * 8 + bj * 4 + wc] = s;
  } else if (pn < 6) {
    const float pos = (float)tok_pos(row), sc = pn >= 4 ? 0.08838834764831845f : 1.f;
    f32x4 o0, o1;
#pragma unroll
    for (int j = 0; j < 4; ++j) { const float inv = fexp2(-(float)(2 * (wc * 16 + fq * 4 + j)) * (13.287712379549449f / 128.f)); float sn, cs; __sincosf(pos * inv, &sn, &cs);
      o0[j] = (v0[j] * cs - v1[j] * sn) * sc; o1[j] = (v1[j] * cs + v0[j] * sn) * sc; }
    st8((pn < 4 ? o.rq : o.rk) + (size_t)row * 512 + ((pn & 1) * 2 + bj) * 128 + wc * 32 + fq * 8, o0, o1);
  } else if (pn < 10) {
    st8((pn < 8 ? o.rv : o.rg) + (size_t)row * 512 + (pn & 1) * 256 + cb, v0, v1);
  } else if (bj == 0 && wc < 2) {
    float s = ((v0[0] * v0[0] + v0[1] * v0[1]) + (v0[2] * v0[2] + v0[3] * v0[3])) + ((v1[0] * v1[0] + v1[1] * v1[1]) + (v1[2] * v1[2] + v1[3] * v1[3]));
    s += __shfl_xor(s, 16); s += __shfl_xor(s, 32);
    if (fq == 0) o.kss2[(size_t)row * 2 + wc] = s;
    const float pos = (float)tok_pos(row); const int i0 = wc * 16 + fq * 4;
    const f32x4 g1 = *(const f32x4*)(o.k_g + 128 + i0), g2 = *(const f32x4*)(o.k_g + 160 + i0);
    f32x4 o0, o1;
#pragma unroll
    for (int j = 0; j < 4; ++j) { const float inv = fexp2(-(float)(2 * (i0 + j)) * (13.287712379549449f / 64.f)); float sn, cs; __sincosf(pos * inv, &sn, &cs);
      const float a1 = v0[j] * g1[j], a2 = v1[j] * g2[j]; o0[j] = a1 * cs - a2 * sn; o1[j] = a2 * cs + a1 * sn; }
    st8(o.kpe + (size_t)row * 64 + wc * 32 + fq * 8, o0, o1);
  }
}
struct EpiG1 { G1Out o; const float* rss; DI const float* scale_src() const { return rss; } DI int scale_n() const { return 16; } DI float scale_inv() const { return 1.f / 1024.f; }
  DI void operator()(const f32x4 (&acc)[2][2][4][2], int pm, int pn, int wr, int wc, int fr, int fq, const float* rsl) const {
#pragma unroll
    for (int ai = 0; ai < 2; ++ai)
#pragma unroll
      for (int m = 0; m < 4; ++m) { const int row = pm * 256 + ai * 128 + wr * 64 + m * 16 + fr; const float rs = rsl[ai * 128 + wr * 64 + m * 16 + fr];
#pragma unroll
        for (int bj = 0; bj < 2; ++bj) g1_emit(o, row, pn, bj, wc, fq, acc[ai][bj][m][0] * rs, acc[ai][bj][m][1] * rs); }
  }
};

struct EpiQ { bf16_t* qf; const float* cqss; const float* q_g; DI const float* scale_src() const { return cqss; } DI int scale_n() const { return 8; } DI float scale_inv() const { return 1.f / 256.f; }
  DI void operator()(const f32x4 (&acc)[2][2][4][2], int pm, int pn, int wr, int wc, int fr, int fq, const float* rsl) const {
    extern __shared__ __attribute__((aligned(16))) unsigned char smem[];
    float* part = (float*)smem;
#pragma unroll
    for (int ai = 0; ai < 2; ++ai)
#pragma unroll
      for (int m = 0; m < 4; ++m) { const int rl = ai * 128 + wr * 64 + m * 16 + fr; const float rs = rsl[rl]; float s = 0.f;
#pragma unroll
        for (int bj = 0; bj < 2; ++bj)
#pragma unroll
          for (int n = 0; n < 2; ++n) { const f32x4 v = acc[ai][bj][m][n] * rs; s += (v[0] * v[0] + v[1] * v[1]) + (v[2] * v[2] + v[3] * v[3]); }
        s += __shfl_xor(s, 16); s += __shfl_xor(s, 32);
        if (fq == 0) part[rl * 4 + wc] = s; }
    __syncthreads();
    const float SCQ = 0.07216878364870322f * LOG2E;
#pragma unroll
    for (int ai = 0; ai < 2; ++ai)
#pragma unroll
      for (int m = 0; m < 4; ++m) { const int rl = ai * 128 + wr * 64 + m * 16 + fr; const int row = pm * 256 + rl;
        const f32x4 pt = *(const f32x4*)(part + rl * 4);
        const float sc = rsl[rl] * rsqrtf(((pt[0] + pt[1]) + (pt[2] + pt[3])) * (1.f / 192.f) + EPSN) * SCQ;
        bf16_t* qo = qf + ((size_t)row * 4 + pn) * 192;
        { const int d = wc * 32 + fq * 8; const f32x4 ga = *(const f32x4*)(q_g + d), gb = *(const f32x4*)(q_g + d + 4); st8(qo + d, acc[ai][0][m][0] * sc * ga, acc[ai][0][m][1] * sc * gb); }
        if (wc < 2) { const int i0 = wc * 16 + fq * 4; const float pos = (float)tok_pos(row);
          const f32x4 g1 = *(const f32x4*)(q_g + 128 + i0), g2 = *(const f32x4*)(q_g + 160 + i0);
          const f32x4 a1 = acc[ai][1][m][0] * sc * g1, a2 = acc[ai][1][m][1] * sc * g2; f32x4 o0, o1;
#pragma unroll
          for (int j = 0; j < 4; ++j) { const float inv = fexp2(-(float)(2 * (i0 + j)) * (13.287712379549449f / 64.f)); float sn, cs; __sincosf(pos * inv, &sn, &cs);
            o0[j] = a1[j] * cs - a2[j] * sn; o1[j] = a2[j] * cs + a1[j] * sn; }
          st8(qo + 128 + wc * 32 + fq * 8, o0, o1); } }
  }
};
struct EpiKV { bf16_t* kf; bf16_t* kvraw; const bf16_t* kpe; const float* kss2; const float* ckvss; const float* k_g;
  DI const float* scale_src() const { return ckvss; } DI int scale_n() const { return 8; } DI float scale_inv() const { return 1.f / 256.f; }
  DI void operator()(const f32x4 (&acc)[2][2][4][2], int pm, int pn, int wr, int wc, int fr, int fq, const float* rsl) const {
    extern __shared__ __attribute__((aligned(16))) unsigned char smem[];
    float* part = (float*)smem;
#pragma unroll
    for (int ai = 0; ai < 2; ++ai)
#pragma unroll
      for (int m = 0; m < 4; ++m) { const int rl = ai * 128 + wr * 64 + m * 16 + fr; const float rs = rsl[rl]; float s = 0.f;
#pragma unroll
        for (int n = 0; n < 2; ++n) { const f32x4 v = acc[ai][0][m][n] * rs; s += (v[0] * v[0] + v[1] * v[1]) + (v[2] * v[2] + v[3] * v[3]); }
        s += __shfl_xor(s, 16); s += __shfl_xor(s, 32);
        if (fq == 0) part[rl * 4 + wc] = s; }
    __syncthreads();
#pragma unroll
    for (int ai = 0; ai < 2; ++ai)
#pragma unroll
      for (int m = 0; m < 4; ++m) { const int rl = ai * 128 + wr * 64 + m * 16 + fr; const int row = pm * 256 + rl; const float rs = rsl[rl];
        const f32x4 pt = *(const f32x4*)(part + rl * 4);
        const float rk_ = rsqrtf((((pt[0] + pt[1]) + (pt[2] + pt[3])) + kss2[(size_t)row * 2] + kss2[(size_t)row * 2 + 1]) * (1.f / 192.f) + EPSN);
        bf16_t* ko = kf + ((size_t)row * 4 + pn) * 192;
        { const int d = wc * 32 + fq * 8; const f32x4 ga = *(const f32x4*)(k_g + d), gb = *(const f32x4*)(k_g + d + 4);
          st8(ko + d, acc[ai][0][m][0] * (rs * rk_) * ga, acc[ai][0][m][1] * (rs * rk_) * gb);
          st8(kvraw + (size_t)row * 1024 + pn * 256 + 128 + d, acc[ai][1][m][0] * rs, acc[ai][1][m][1] * rs); }
        { const int c = wc * 16 + fq * 4; const u32x2 raw = *(const u32x2*)(kpe + (size_t)row * 64 + c);
          f32x4 kp = {__uint_as_float(raw[0] << 16), __uint_as_float(raw[0] & 0xffff0000u), __uint_as_float(raw[1] << 16), __uint_as_float(raw[1] & 0xffff0000u)};
          st4(ko + 128 + c, kp * rk_); } }
  }
};

template <class Epi, bool PERMB = false>
DI void gemm_tile(const bf16_t* __restrict__ A, int lda, const bf16_t* __restrict__ Bt, int K, int pm, int pn, const Epi& epi) {
  const int TX = opq((int)threadIdx.x);
  extern __shared__ __attribute__((aligned(16))) unsigned char smem[];
  bf16_t* shm = (bf16_t*)smem;
#define SA(b, h) (shm + ((b) * 2 + (h)) * HT)
#define SB(b, h) (shm + (4 + (b) * 2 + (h)) * HT)
#define STAGE(P, BASE, LD, br, kt, VO) do { const char* _ub = (const char*)((BASE) + (long)(br) * (LD) + (long)(kt) * BK); \
    __builtin_amdgcn_global_load_lds((const unsigned*)(_ub + VO[0]), (unsigned*)((char*)(P) + sb0), 16, 0, 0); \
    __builtin_amdgcn_global_load_lds((const unsigned*)(_ub + VO[1]), (unsigned*)((char*)(P) + sb0 + 8192), 16, 0, 0); } while (0)
#define LDA(dst, b, h) _Pragma("unroll") for (int m = 0; m < 4; ++m) _Pragma("unroll") for (int k = 0; k < 2; ++k) \
    dst[m][k] = *reinterpret_cast<const bf16x8*>((char*)SA(b, h) + aoff + m * 2048 + k * 1024)
#define LDB(dst, b, h) _Pragma("unroll") for (int n = 0; n < 2; ++n) _Pragma("unroll") for (int k = 0; k < 2; ++k) \
    dst[n][k] = *reinterpret_cast<const bf16x8*>((char*)SB(b, h) + boff + n * 2048 + k * 1024)
#define MMA(ai, bj, At_, Bt_) do { __builtin_amdgcn_s_setprio(1); \
    _Pragma("unroll") for (int m = 0; m < 4; ++m) _Pragma("unroll") for (int n = 0; n < 2; ++n) _Pragma("unroll") for (int k = 0; k < 2; ++k) \
      acc[ai][bj][m][n] = __builtin_amdgcn_mfma_f32_16x16x32_bf16(Bt_[n][k], At_[m][k], acc[ai][bj][m][n], 0, 0, 0); \
    __builtin_amdgcn_s_setprio(0); } while (0)
#define WAIT_V(n) asm volatile("s_waitcnt vmcnt(" #n ")" ::: "memory")
#define WAIT_L(n) asm volatile("s_waitcnt lgkmcnt(" #n ")" ::: "memory")
#define BAR __builtin_amdgcn_s_barrier()
#define SCHED __builtin_amdgcn_sched_barrier(0)
  const int brow = pm * BM, bcol = pn * BM;
  const int wid = TX >> 6, lane = TX & 63, wr = wid >> 2, wc = wid & 3, fr = lane & 15, fq = lane >> 4;
  const int sb0 = TX * 16;
  unsigned voA[2], voB[2];
#pragma unroll
  for (int i = 0; i < 2; ++i) { int R, C; stage_rc(sb0 + i * 8192, R, C); voA[i] = (unsigned)(R * lda + C) * 2u;
    const int rho = R & 31, Rb = PERMB ? ((R & ~31) + 8 * ((rho & 15) >> 2) + 4 * (rho >> 4) + (rho & 3)) : R;
    voB[i] = (unsigned)(Rb * K + C) * 2u; }
  const int aoff = lds_byte(wr * 64 + fr, fq * 8), boff = lds_byte(wc * 32 + fr, fq * 8);
  f32x4 acc[2][2][4][2] = {};
  bf16x8 At[4][2], B0[2][2], B1[2][2];
  const int nt = K / BK;
  float* rsl = (float*)(smem + 131072 + 256);
  const float* rsrc = epi.scale_src();
  f32x4 q0 = {0.f, 0.f, 0.f, 0.f}, q1 = q0, q2 = q0, q3 = q0;
  const int rsn = epi.scale_n();
  if (rsrc && TX < 256) { const f32x4* q = (const f32x4*)(rsrc + (size_t)(brow + TX) * rsn); q0 = q[0]; q1 = q[1]; if (rsn == 16) { q2 = q[2]; q3 = q[3]; } }
  STAGE(SB(0, 0), Bt, K, bcol, 0, voB); STAGE(SA(0, 0), A, lda, brow, 0, voA);
  STAGE(SB(0, 1), Bt, K, bcol + HALF, 0, voB); STAGE(SA(0, 1), A, lda, brow + HALF, 0, voA);
  if (wr == 1) BAR;
  WAIT_V(4); BAR;
  if (rsrc && TX < 256) rsl[TX] = rsqrtf(((q0[0] + q0[1] + q0[2] + q0[3]) + (q1[0] + q1[1] + q1[2] + q1[3]) + (q2[0] + q2[1] + q2[2] + q2[3]) + (q3[0] + q3[1] + q3[2] + q3[3])) * epi.scale_inv() + EPSN);
  STAGE(SB(1, 0), Bt, K, bcol, 1, voB); STAGE(SA(1, 0), A, lda, brow, 1, voA); STAGE(SB(1, 1), Bt, K, bcol + HALF, 1, voB);
  WAIT_V(6); BAR;
  for (int t = 0; t < nt - 2; t += 2) {
    LDB(B0, 0, 0); SCHED; LDA(At, 0, 0); STAGE(SA(1, 1), A, lda, brow + HALF, t + 1, voA);
    WAIT_L(8); BAR; WAIT_L(0); MMA(0, 0, At, B0); BAR; SCHED;
    LDB(B1, 0, 1); STAGE(SB(0, 0), Bt, K, bcol, t + 2, voB);
    BAR; WAIT_L(0); MMA(0, 1, At, B1); BAR;
    LDA(At, 0, 1); STAGE(SA(0, 0), A, lda, brow, t + 2, voA);
    BAR; WAIT_L(0); MMA(1, 0, At, B0); BAR; SCHED;
    STAGE(SB(0, 1), Bt, K, bcol + HALF, t + 2, voB);
    WAIT_V(6); BAR; MMA(1, 1, At, B1); BAR;
    LDB(B0, 1, 0); SCHED; LDA(At, 1, 0); STAGE(SA(0, 1), A, lda, brow + HALF, t + 2, voA);
    WAIT_L(8); BAR; WAIT_L(0); MMA(0, 0, At, B0); BAR; SCHED;
    LDB(B1, 1, 1); STAGE(SB(1, 0), Bt, K, bcol, t + 3, voB);
    BAR; WAIT_L(0); MMA(0, 1, At, B1); BAR;
    LDA(At, 1, 1); STAGE(SA(1, 0), A, lda, brow, t + 3, voA);
    BAR; WAIT_L(0); MMA(1, 0, At, B0); BAR; SCHED;
    STAGE(SB(1, 1), Bt, K, bcol + HALF, t + 3, voB);
    WAIT_V(6); BAR; MMA(1, 1, At, B1); BAR;
  }
  { LDB(B0, 0, 0); LDA(At, 0, 0); STAGE(SA(1, 1), A, lda, brow + HALF, nt - 1, voA);
    BAR; WAIT_L(0); MMA(0, 0, At, B0); BAR;
    LDB(B1, 0, 1); BAR; WAIT_L(0); MMA(0, 1, At, B1); BAR;
    LDA(At, 0, 1); WAIT_V(4); BAR; WAIT_L(0); MMA(1, 0, At, B0); MMA(1, 1, At, B1); BAR; }
  { LDB(B0, 1, 0); LDA(At, 1, 0); WAIT_V(2); BAR; WAIT_L(0); MMA(0, 0, At, B0); BAR;
    LDB(B1, 1, 1); WAIT_V(0); BAR; WAIT_L(0); MMA(0, 1, At, B1); BAR;
    LDA(At, 1, 1); BAR; WAIT_L(0); MMA(1, 0, At, B0); MMA(1, 1, At, B1); BAR; }
  if (wr == 0) BAR;
  epi(acc, pm, pn, wr, wc, fr, fq, rsl);
  __syncthreads();
#undef SA
#undef SB
#undef STAGE
#undef LDA
#undef LDB
#undef MMA
}

template <class Epi, bool PERMB = false>
DI void gemm_phase(const bf16_t* A, int lda, const bf16_t* Bt, int K, int nM, int nN, const Epi& epi) {
  for (int i = 0;; ++i) { int pm, pn; if (!tile_order(i * (int)gridDim.x + (int)blockIdx.x, nM, nN, pm, pn)) break; gemm_tile<Epi, PERMB>(A, lda, Bt, K, pm, pn, epi); }
}

DI float row_rsN(const float* __restrict__ p, int n4, float invw) {
  float s = 0.f;
  for (int i = 0; i < n4; ++i) { const f32x4 a = ((const f32x4*)p)[i]; s += (a[0] + a[1]) + (a[2] + a[3]); }
  return rsqrtf(s * invw + EPSN);
}
template <int MODE>
DI void skinny_task(const bf16_t* __restrict__ A, int lda, const bf16_t* __restrict__ Bt, int K, int t, bf16_t* O, int ldc, float* hx, float* sl, int sl_stride, int sl_n4, float sl_inv, const G1Out* g1o) {
  const int TX = opq((int)threadIdx.x);
  const int lane = TX & 63, w = TX >> 6, fr = lane & 15, fq = lane >> 4;
  const int row = MREAL + 16 * w + fr;
  const int c0 = 16 * t;
  const int n0 = MODE == 2 ? ((c0 >> 7) * 256 + (c0 & 127)) : (MODE == 3 ? ((t >> 3) * 256 + ((t >> 2) & 1) * 128 + (t & 3) * 32) : c0);
  const bf16_t* ap = A + (size_t)row * lda + 8 * fq;
  const bf16_t* bp0 = Bt + (size_t)(n0 + (MODE == 3 ? 8 * (fr >> 2) + (fr & 3) : fr)) * K + 8 * fq;
  const bf16_t* bp1 = bp0 + (size_t)(MODE == 3 ? 4 : 128) * K;
  constexpr bool TWO = MODE >= 2;
  f32x4 acc0 = {0.f, 0.f, 0.f, 0.f}, acc1 = {0.f, 0.f, 0.f, 0.f};
  constexpr int NS = TWO ? 4 : 8, KB_ = NS * 32;
  bf16x8 a[NS], b0[NS], b1[NS], a2[NS], c0v[NS], c1v[NS];
#define SK_LOAD(A_, B0_, B1_, k_) _Pragma("unroll") for (int s = 0; s < NS; ++s) { A_[s] = *(const bf16x8*)(ap + (k_) + 32 * s); B0_[s] = *(const bf16x8*)(bp0 + (k_) + 32 * s); if (TWO) B1_[s] = *(const bf16x8*)(bp1 + (k_) + 32 * s); }
#define SK_MMA(A_, B0_, B1_) _Pragma("unroll") for (int s = 0; s < NS; ++s) { acc0 = __builtin_amdgcn_mfma_f32_16x16x32_bf16(B0_[s], A_[s], acc0, 0, 0, 0); if (TWO) acc1 = __builtin_amdgcn_mfma_f32_16x16x32_bf16(B1_[s], A_[s], acc1, 0, 0, 0); }
  SK_LOAD(a, b0, b1, 0);
  for (int k = 0; k < K; k += 2 * KB_) {
    if (k + KB_ < K) SK_LOAD(a2, c0v, c1v, k + KB_);
    SK_MMA(a, b0, b1);
    if (k + KB_ < K) { if (k + 2 * KB_ < K) SK_LOAD(a, b0, b1, k + 2 * KB_); SK_MMA(a2, c0v, c1v); }
  }
#undef SK_LOAD
#undef SK_MMA
  const int col = c0 + 4 * fq;
  const float rs = (MODE != 1 && sl) ? row_rsN(sl + (size_t)(sl_stride == 64 ? row - MREAL : row) * sl_stride, sl_n4, sl_inv) : 1.f;
  if (MODE == 0) { st4(O + (size_t)row * ldc + col, acc0 * rs); }
  else if (MODE == 1) { float* rp = hx + (size_t)(row - MREAL) * 1024 + col; f32x4 v = *(f32x4*)rp; v += acc0; *(f32x4*)rp = v;
    st4(O + (size_t)row * 1024 + col, v);
    float s = (v[0] * v[0] + v[1] * v[1]) + (v[2] * v[2] + v[3] * v[3]); s += __shfl_xor(s, 16); s += __shfl_xor(s, 32);
    if (fq == 0) sl[(size_t)(row - MREAL) * 64 + t] = s; }
  else if (MODE == 2) { f32x4 o;
#pragma unroll
    for (int j = 0; j < 4; ++j) { const float g = acc0[j] * rs; o[j] = g * __builtin_amdgcn_rcpf(1.f + __expf(-g)) * (acc1[j] * rs); }
    st4(O + (size_t)row * DFF + col, o); }
  else { g1_emit(*g1o, row, t >> 3, (t >> 2) & 1, t & 3, fq, acc0 * rs, acc1 * rs); }
}
template <int MODE>
DI void skinny_task2(const bf16_t* __restrict__ A, int lda, const bf16_t* __restrict__ Bt, int K, int tp, bf16_t* O, const float* sl, const G1Out* g1o) {
  const int TX = opq((int)threadIdx.x);
  const int lane = TX & 63, w = TX >> 6, fr = lane & 15, fq = lane >> 4;
  const int row = MREAL + 16 * w + fr;
  const bf16_t* ap = A + (size_t)row * lda + 8 * fq;
  const bf16_t* bp[4];
#pragma unroll
  for (int u = 0; u < 2; ++u) { const int t = 2 * tp + u, c0 = 16 * t;
    const int n0 = MODE == 2 ? ((c0 >> 7) * 256 + (c0 & 127)) : ((t >> 3) * 256 + ((t >> 2) & 1) * 128 + (t & 3) * 32);
    bp[2 * u] = Bt + (size_t)(n0 + (MODE == 3 ? 8 * (fr >> 2) + (fr & 3) : fr)) * K + 8 * fq;
    bp[2 * u + 1] = bp[2 * u] + (size_t)(MODE == 3 ? 4 : 128) * K; }
  f32x4 acc[4];
#pragma unroll
  for (int i = 0; i < 4; ++i) acc[i] = (f32x4){0.f, 0.f, 0.f, 0.f};
  constexpr int NS = 4, KB_ = NS * 32;
  bf16x8 a0[NS], b0[4][NS], a1[NS], b1[4][NS];
#define SK2_LOAD(A_, B_, k_) _Pragma("unroll") for (int s = 0; s < NS; ++s) { A_[s] = *(const bf16x8*)(ap + (k_) + 32 * s); _Pragma("unroll") for (int i = 0; i < 4; ++i) B_[i][s] = *(const bf16x8*)(bp[i] + (k_) + 32 * s); }
#define SK2_MMA(A_, B_) _Pragma("unroll") for (int s = 0; s < NS; ++s) { _Pragma("unroll") for (int i = 0; i < 4; ++i) acc[i] = __builtin_amdgcn_mfma_f32_16x16x32_bf16(B_[i][s], A_[s], acc[i], 0, 0, 0); }
  SK2_LOAD(a0, b0, 0);
  for (int k = 0; k < K; k += 2 * KB_) {
    if (k + KB_ < K) SK2_LOAD(a1, b1, k + KB_);
    SK2_MMA(a0, b0);
    if (k + KB_ < K) { if (k + 2 * KB_ < K) SK2_LOAD(a0, b0, k + 2 * KB_); SK2_MMA(a1, b1); }
  }
#undef SK2_LOAD
#undef SK2_MMA
  const float rs = row_rsN(sl + (size_t)(row - MREAL) * 64, 16, 1.f / 1024.f);
#pragma unroll
  for (int u = 0; u < 2; ++u) { const int t = 2 * tp + u;
    if (MODE == 2) { f32x4 o;
#pragma unroll
      for (int j = 0; j < 4; ++j) { const float g = acc[2 * u][j] * rs; o[j] = g * __builtin_amdgcn_rcpf(1.f + __expf(-g)) * (acc[2 * u + 1][j] * rs); }
      st4(O + (size_t)row * DFF + 16 * t + 4 * fq, o); }
    else g1_emit(*g1o, row, t >> 3, (t >> 2) & 1, t & 3, fq, acc[2 * u] * rs, acc[2 * u + 1] * rs); }
}
template <int MODE>
DI void skinny_phase2(const bf16_t* A, int lda, const bf16_t* Bt, int K, int npair, bf16_t* O, const float* sl, const G1Out* g1o) {
  for (int t = (int)gridDim.x - 1 - (int)blockIdx.x; t < npair; t += (int)gridDim.x) skinny_task2<MODE>(A, lda, Bt, K, t, O, sl, g1o);
}

template <int MODE>
DI void skinny_phase(const bf16_t* A, int lda, const bf16_t* Bt, int K, int ntask, bf16_t* O, int ldc, float* hx, float* sl, int sl_stride, int sl_n4, float sl_inv, const G1Out* g1o) {
  for (int t = (int)gridDim.x - 1 - (int)blockIdx.x; t < ntask; t += (int)gridDim.x) skinny_task<MODE>(A, lda, Bt, K, t, O, ldc, hx, sl, sl_stride, sl_n4, sl_inv, g1o);
}

template <int NSTEPS>
DI void skinny_res_task(const bf16_t* __restrict__ A, int lda, const bf16_t* __restrict__ Bt, int K, int task, bf16_t* hbp, float* hxp, float* rssmp) {
  extern __shared__ __attribute__((aligned(16))) unsigned char smem[];
  const int TX = opq((int)threadIdx.x);
  const int lane = TX & 63, w = TX >> 6, fr = lane & 15, fq = lane >> 4;
  const int rgp = task & 7, cg = task >> 3;
  const int row = MREAL + 16 * rgp + fr;
  const int k0 = w * (NSTEPS * 32);
  const bf16_t* ap = A + (size_t)row * lda + k0 + 8 * fq;
  const bf16_t* bp0 = Bt + (size_t)(16 * cg + fr) * K + k0 + 8 * fq;
  const bf16_t* bp1 = bp0 + (size_t)512 * K;
  bf16x8 a[NSTEPS], b0[NSTEPS], b1[NSTEPS];
#pragma unroll
  for (int s = 0; s < NSTEPS; ++s) { a[s] = *(const bf16x8*)(ap + 32 * s); b0[s] = *(const bf16x8*)(bp0 + 32 * s); b1[s] = *(const bf16x8*)(bp1 + 32 * s); }
  f32x4 acc0 = {0.f, 0.f, 0.f, 0.f}, acc1 = {0.f, 0.f, 0.f, 0.f};
#pragma unroll
  for (int s = 0; s < NSTEPS; ++s) { acc0 = __builtin_amdgcn_mfma_f32_16x16x32_bf16(b0[s], a[s], acc0, 0, 0, 0); acc1 = __builtin_amdgcn_mfma_f32_16x16x32_bf16(b1[s], a[s], acc1, 0, 0, 0); }
  f32x4* part = (f32x4*)smem;
  part[w * 64 + lane] = acc0; part[512 + w * 64 + lane] = acc1;
  __syncthreads();
  if (w < 2) {
    f32x4 v = part[w * 512 + lane];
#pragma unroll
    for (int j = 1; j < 8; ++j) v += part[w * 512 + j * 64 + lane];
    const int cgw = cg + 32 * w, col = 16 * cgw + 4 * fq;
    float* rp = hxp + (size_t)(row - MREAL) * 1024 + col; v += *(const f32x4*)rp; *(f32x4*)rp = v;
    st4(hbp + (size_t)row * 1024 + col, v);
    float s = (v[0] * v[0] + v[1] * v[1]) + (v[2] * v[2] + v[3] * v[3]); s += __shfl_xor(s, 16); s += __shfl_xor(s, 32);
    if (fq == 0) rssmp[(size_t)(row - MREAL) * 64 + cgw] = s;
  }
  __syncthreads();
}

DI void conv_w(const float* __restrict__ src, int K, int Nsrc, bf16_t* __restrict__ dst, int Nd, int mode, const float* __restrict__ g, int blk, int nblk) {
  extern __shared__ __attribute__((aligned(16))) unsigned char smem[];
  const int TX = opq((int)threadIdx.x);
  if (blk < 0) return;
  const int lane = TX & 63, w = TX >> 6;
  const int ntn = Nd >> 6, ntiles = ntn * (K >> 7);
  for (int t = blk; t < ntiles; t += nblk) {
    const int n0 = (t % ntn) << 6, k0 = (t / ntn) << 7;
    const int n = n0 + lane;
    int sc = n;
    if (mode == 1) { const int tn = n >> 8, hf = (n >> 7) & 1, i = n & 127; sc = hf * DFF + tn * 128 + i; }
    else if (mode == 2) { const int tn = n >> 8, c = n & 255;
      if (tn < 2) sc = n;
      else if (tn < 6) { const int cc = c & 127; sc = (tn < 4 ? 576 : 1088) + (((tn & 1) * 2 + (c >> 7)) * 128) + ((cc >> 2) & 1) * 64 + (cc >> 5) * 16 + ((cc >> 3) & 3) * 4 + (cc & 3); }
      else if (tn < 8) sc = 1600 + (tn - 6) * 256 + c;
      else if (tn < 10) sc = 2112 + (tn - 8) * 256 + c;
      else sc = c < 64 ? 512 + ((c >> 2) & 1) * 32 + (c >> 5) * 16 + ((c >> 3) & 3) * 4 + (c & 3) : -1; }
    else if (mode == 3) { const int hd = n >> 8, c = n & 255;
      if (c < 128) sc = hd * 192 + c;
      else if (c < 192) { const int pp = c - 128; sc = hd * 192 + 128 + ((pp >> 2) & 1) * 32 + (pp >> 5) * 16 + ((pp >> 3) & 3) * 4 + (pp & 3); }
      else sc = -1; }
    else if (n >= Nsrc) sc = -1;
    u32x4 o0 = {0u, 0u, 0u, 0u}, o1 = {0u, 0u, 0u, 0u};
    if (sc >= 0) { const int kb = k0 + 8 * w; const float* p = src + (size_t)kb * Nsrc + sc;
      float v[16];
#pragma unroll
      for (int j = 0; j < 8; ++j) { v[j] = p[(size_t)j * Nsrc]; v[8 + j] = p[(size_t)(64 + j) * Nsrc]; }
      if (g) {
#pragma unroll
        for (int j = 0; j < 8; ++j) { v[j] *= g[kb + j]; v[8 + j] *= g[kb + 64 + j]; } }
      o0[0] = pack2(v[0], v[1]); o0[1] = pack2(v[2], v[3]); o0[2] = pack2(v[4], v[5]); o0[3] = pack2(v[6], v[7]);
      o1[0] = pack2(v[8], v[9]); o1[1] = pack2(v[10], v[11]); o1[2] = pack2(v[12], v[13]); o1[3] = pack2(v[14], v[15]); }
    *(u32x4*)(smem + lane * 272 + w * 16) = o0; *(u32x4*)(smem + lane * 272 + 128 + w * 16) = o1;
    __syncthreads();
#pragma unroll
    for (int i = 0; i < 2; ++i) { const int idx = TX + 512 * i, rn = idx >> 4, ch = idx & 15;
      *(u32x4*)(dst + (size_t)(n0 + rn) * K + k0 + ch * 8) = *(const u32x4*)(smem + rn * 272 + ch * 16); }
    __syncthreads();
  }
}

DI void phase_init(const Params& p, bf16_t* hb, float* hx, float* rss, float* rssm) {
  const int TX = opq((int)threadIdx.x);
  const int lane = TX & 63, gw = blockIdx.x * 8 + (TX >> 6), nw = gridDim.x * 8;
  for (int r = gw; r < MV; r += nw) {
    f32x4 v[4];
    float* drow = r < MREAL ? p.out + (size_t)r * 1024 : hx + (size_t)(r - MREAL) * 1024;
    const float* src = r < MREAL ? p.x + (size_t)r * 1024 : p.meta + (size_t)((r - MREAL) & 15) * 1024;
    float ss = 0.f;
#pragma unroll
    for (int i = 0; i < 2; ++i) { const int c0 = i * 512 + lane * 8;
      v[2 * i] = *(const f32x4*)(src + c0); v[2 * i + 1] = *(const f32x4*)(src + c0 + 4);
      if (r >= MREAL) { *(f32x4*)(drow + c0) = v[2 * i]; *(f32x4*)(drow + c0 + 4) = v[2 * i + 1]; }
      st8(hb + (size_t)r * 1024 + c0, v[2 * i], v[2 * i + 1]);
#pragma unroll
      for (int q = 0; q < 2; ++q) { const f32x4 t = v[2 * i + q]; ss += (t[0] * t[0] + t[1] * t[1]) + (t[2] * t[2] + t[3] * t[3]); } }
    ss = wave_sum(ss);
    if (r < MREAL) { if (lane < 16) rss[(size_t)r * 16 + lane] = lane == 0 ? ss : 0.f; }
    else rssm[(size_t)(r - MREAL) * 64 + lane] = lane == 0 ? ss : 0.f;
  }
}

DI void phase_r3(const bf16_t* __restrict__ qraw, const bf16_t* __restrict__ kvraw, const bf16_t* __restrict__ kpe, const float* __restrict__ kss,
                 const float* __restrict__ q_g, const float* __restrict__ k_g, bf16_t* qf, bf16_t* kf) {
  const int TX = opq((int)threadIdx.x);
  const int lane = TX & 63, gw = blockIdx.x * 8 + (TX >> 6), nw = gridDim.x * 8;
  const float inv64 = fexp2(-(float)(2 * (lane & 31)) * (13.287712379549449f / 64.f));
  const float SCQ = 0.07216878364870322f * LOG2E;
  const int pl = (((lane & 31) >> 4) << 5) + ((((lane & 31) >> 2) & 3) << 3) + ((lane >> 5) << 2) + (lane & 3);
  const float qg0 = q_g[lane], qg1 = q_g[64 + lane], qg2 = q_g[128 + lane], kg0 = k_g[lane], kg1 = k_g[64 + lane];
  for (int it = gw; it < (MV - MREAL) * 4; it += nw) { const int r = MREAL + (it >> 2), h = it & 3;
    float sn, cs; __sincosf((float)tok_pos(r) * inv64, &sn, &cs);
    const float kssr = kss[(size_t)r * 2] + kss[(size_t)r * 2 + 1];
    const float kp = bf2f(kpe[(size_t)r * 64 + lane]);
    {
      const bf16_t* qp = qraw + (size_t)(r - MREAL) * 1024 + h * 256;
      const float v0 = bf2f(qp[lane]), v1 = bf2f(qp[64 + lane]), v2 = bf2f(qp[128 + pl]);
      const float rs = rsqrtf(wave_sum(v0 * v0 + v1 * v1 + v2 * v2) * (1.f / 192.f) + EPSN) * SCQ;
      const float t2 = v2 * rs * qg2, oth = __shfl_xor(t2, 32);
      const float o2 = lane < 32 ? t2 * cs - oth * sn : t2 * cs + oth * sn;
      bf16_t* qo = qf + ((size_t)r * 4 + h) * 192;
      qo[lane] = f2bf(v0 * rs * qg0); qo[64 + lane] = f2bf(v1 * rs * qg1); qo[128 + pl] = f2bf(o2);
      const bf16_t* kq = kvraw + (size_t)r * 1024 + h * 256;
      const float k0 = bf2f(kq[lane]), k1 = bf2f(kq[64 + lane]);
      const float rk_ = rsqrtf((wave_sum(k0 * k0 + k1 * k1) + kssr) * (1.f / 192.f) + EPSN);
      bf16_t* ko = kf + ((size_t)r * 4 + h) * 192;
      ko[lane] = f2bf(k0 * rk_ * kg0); ko[64 + lane] = f2bf(k1 * rk_ * kg1); ko[128 + lane] = f2bf(kp * rk_);
    }
  }
}

DI void phase_scan(bf16_t* kst) {
  const int TX = opq((int)threadIdx.x);
  const long gt = (long)blockIdx.x * 512 + TX, gn = (long)gridDim.x * 512;
  for (long idx = gt; idx < 32L * 8192; idx += gn) {
    const int bh = (int)(idx >> 13), ed = (int)(idx & 8191) * 2, h = bh & 3;
    const float g128 = fexp2(128.f * __log2f(1.f - fexp2(-5.f - (float)h)));
    unsigned* base = (unsigned*)(kst + (size_t)bh * 17 * 16384 + ed);
    unsigned v[17];
#pragma unroll
    for (int c = 0; c < 17; ++c) v[c] = base[(size_t)c * 8192];
    float s0 = 0.f, s1 = 0.f;
#pragma unroll
    for (int c = 0; c < 17; ++c) { const float t0 = __uint_as_float(v[c] << 16), t1 = __uint_as_float(v[c] & 0xffff0000u);
      base[(size_t)c * 8192] = pack2(s0, s1); s0 = s0 * g128 + t0; s1 = s1 * g128 + t1; }
  }
}

DI void kvc_unit(const bf16_t* __restrict__ rk, const bf16_t* __restrict__ rv, bf16_t* kst, int b, int h, int c) {
  const int TX = opq((int)threadIdx.x);
  extern __shared__ __attribute__((aligned(16))) unsigned char smem[];
  unsigned char* Vs = smem; unsigned char* Ks = smem + 40960;
  const int tid = TX, lane = tid & 63, w = tid >> 6, eb = w & 3, dh = w >> 2, r = lane & 31, hh = lane >> 5;
  const int q4 = (lane & 15) >> 2, p4 = lane & 3, blk = (lane >> 4) & 1;
  const float log2g = __log2f(1.f - fexp2(-5.f - (float)h));
#pragma unroll
  for (int i = 0; i < 4; ++i) { const int idx = tid + 512 * i, m = idx >> 4, ch = idx & 15; const int row = ret_row(b, c, m);
    u32x4 kv = {0u, 0u, 0u, 0u}, vv = {0u, 0u, 0u, 0u};
    if (row >= 0) { kv = *(const u32x4*)(rk + (size_t)row * 512 + h * 128 + ch * 8); vv = *(const u32x4*)(rv + (size_t)row * 512 + h * 128 + ch * 8); }
    const float zeta = fexp2((float)(127 - m) * log2g);
#pragma unroll
    for (int j = 0; j < 4; ++j) kv[j] = pack2(__uint_as_float(kv[j] << 16) * zeta, __uint_as_float(kv[j] & 0xffff0000u) * zeta);
    *(u32x4*)(Ks + (m * 160 + ch * 8) * 2) = kv; *(u32x4*)(Vs + (m * 160 + ch * 8) * 2) = vv; }
  __syncthreads();
  f32x16 acc[2];
#pragma unroll
  for (int i = 0; i < 16; ++i) { acc[0][i] = 0.f; acc[1][i] = 0.f; }
#pragma unroll
  for (int s = 0; s < 8; ++s) {
    const int k0 = 16 * s + 8 * hh + q4;
    const unsigned char* pa = Vs + (k0 * 160 + 32 * eb + 16 * blk + 4 * p4) * 2;
    const bf16x8 a = tr8(pa, pa + 4 * 160 * 2);
#pragma unroll
    for (int db = 0; db < 2; ++db) { const unsigned char* pb = Ks + (k0 * 160 + 64 * dh + 32 * db + 16 * blk + 4 * p4) * 2;
      const bf16x8 bb = tr8(pb, pb + 4 * 160 * 2); acc[db] = mfma32(a, bb, acc[db]); }
  }
  bf16_t* o = kst + ((size_t)((b * 4 + h) * 17 + c)) * 16384;
#pragma unroll
  for (int db = 0; db < 2; ++db)
#pragma unroll
    for (int i = 0; i < 16; ++i) o[(32 * eb + crow(i, hh)) * 128 + 64 * dh + 32 * db + r] = f2bf(acc[db][i]);
  __syncthreads();
}

DI void ret_unit(const bf16_t* __restrict__ rq, const bf16_t* __restrict__ rk, const bf16_t* __restrict__ rv, const bf16_t* __restrict__ rg,
                 const bf16_t* __restrict__ kst, bf16_t* y, const float* __restrict__ rn_g, const float* __restrict__ rn_b, int b, int h, int c) {
  const int TX = opq((int)threadIdx.x);
  extern __shared__ __attribute__((aligned(16))) unsigned char smem[];
  unsigned char* Ks = smem; unsigned char* Vs = smem + 34816; unsigned char* Ss = smem + 75776;
  float* comb = (float*)smem;
  const int tid = TX, lane = tid & 63, w = tid >> 6, nb = w & 3, grp = w >> 2, r = lane & 31, hh = lane >> 5;
  const int q4 = (lane & 15) >> 2, p4 = lane & 3, blk = (lane >> 4) & 1;
  const float log2g = __log2f(1.f - fexp2(-5.f - (float)h));
  const bf16_t* st = kst + ((size_t)((b * 4 + h) * 17 + c)) * 16384;
#pragma unroll
  for (int i = 0; i < 4; ++i) { const int idx = tid + 512 * i, m = idx >> 4, ch = idx & 15; const int row = ret_row(b, c, m);
    u32x4 kv = {0u, 0u, 0u, 0u}, vv = {0u, 0u, 0u, 0u};
    if (row >= 0) { kv = *(const u32x4*)(rk + (size_t)row * 512 + h * 128 + ch * 8); vv = *(const u32x4*)(rv + (size_t)row * 512 + h * 128 + ch * 8); }
    *(u32x4*)(Ks + (m * 136 + ch * 8) * 2) = kv; *(u32x4*)(Vs + (m * 160 + ch * 8) * 2) = vv;
    *(u32x4*)(Ss + (m * 136 + ch * 8) * 2) = *(const u32x4*)(st + m * 128 + ch * 8); }
  const int n = 32 * nb + r;
  const int qrow = ret_row(b, c, n);
  bf16x8 qfr[8];
#pragma unroll
  for (int s = 0; s < 8; ++s) { if (qrow >= 0) qfr[s] = *(const bf16x8*)(rq + (size_t)qrow * 512 + h * 128 + 16 * s + 8 * hh); else qfr[s] = (bf16x8){0, 0, 0, 0, 0, 0, 0, 0}; }
  __syncthreads();
  f32x16 acc[4];
#pragma unroll
  for (int eb = 0; eb < 4; ++eb)
#pragma unroll
    for (int i = 0; i < 16; ++i) acc[eb][i] = 0.f;
  const bool active = c > 0 || (nb == 3 && grp == 1);
  if (active) {
#pragma unroll
  for (int eb = 0; eb < 4; ++eb)
#pragma unroll
    for (int s2 = 0; s2 < 4; ++s2) { const bf16x8 a = *(const bf16x8*)(Ss + ((32 * eb + r) * 136 + 16 * (4 * grp + s2) + 8 * hh) * 2);
      const bf16x8 qv = grp ? qfr[4 + s2] : qfr[s2];
      acc[eb] = mfma32(a, qv, acc[eb]); }
  const float xi = fexp2((float)(n + 1) * log2g);
#pragma unroll
  for (int eb = 0; eb < 4; ++eb)
#pragma unroll
    for (int i = 0; i < 16; ++i) acc[eb][i] *= xi;
  bf16x8 pk[2][2];
#pragma unroll
  for (int mb = 0; mb < 2; ++mb) {
    f32x16 x;
#pragma unroll
    for (int i = 0; i < 16; ++i) x[i] = 0.f;
#pragma unroll
    for (int s = 0; s < 8; ++s) { const bf16x8 a = *(const bf16x8*)(Ks + ((64 * grp + 32 * mb + r) * 136 + 16 * s + 8 * hh) * 2); x = mfma32(a, qfr[s], x); }
#pragma unroll
    for (int i = 0; i < 16; ++i) { const int dd = n - (64 * grp + 32 * mb + crow(i, hh)); x[i] = dd >= 0 ? x[i] * fexp2((float)dd * log2g) : 0.f; }
    pk[mb][0] = pack8(x, 0); pk[mb][1] = pack8(x, 1);
  }
#pragma unroll
  for (int eb = 0; eb < 4; ++eb)
#pragma unroll
    for (int mb = 0; mb < 2; ++mb)
#pragma unroll
      for (int s2 = 0; s2 < 2; ++s2) { const int m0 = 64 * grp + 32 * mb + 16 * s2 + 4 * hh + q4;
        const unsigned char* pa = Vs + (m0 * 160 + 32 * eb + 16 * blk + 4 * p4) * 2;
        const bf16x8 a = tr8(pa, pa + 8 * 160 * 2); acc[eb] = mfma32(a, pk[mb][s2], acc[eb]); }
  }
  __syncthreads();
  float* cb = comb + (size_t)nb * 64 * 64 + lane;
  if (grp == 1) {
#pragma unroll
    for (int eb = 0; eb < 4; ++eb)
#pragma unroll
      for (int i = 0; i < 16; ++i) cb[(eb * 16 + i) * 64] = acc[eb][i];
  }
  __syncthreads();
  if (grp == 0) {
    float sm = 0.f;
#pragma unroll
    for (int eb = 0; eb < 4; ++eb)
#pragma unroll
      for (int i = 0; i < 16; ++i) { acc[eb][i] += cb[(eb * 16 + i) * 64]; sm += acc[eb][i]; }
    sm += __shfl_xor(sm, 32);
    const float mu = sm * (1.f / 128.f);
    float vs = 0.f;
#pragma unroll
    for (int eb = 0; eb < 4; ++eb)
#pragma unroll
      for (int i = 0; i < 16; ++i) { const float d = acc[eb][i] - mu; vs += d * d; }
    vs += __shfl_xor(vs, 32);
    const float rs = rsqrtf(vs * (1.f / 128.f) + EPSN);
    unsigned char* stg = (unsigned char*)(comb + (size_t)nb * 64 * 64);
    if (qrow >= 0) {
#pragma unroll
      for (int eb = 0; eb < 4; ++eb)
#pragma unroll
        for (int g4 = 0; g4 < 4; ++g4) { const int el = 32 * eb + 8 * g4 + 4 * hh, e0 = h * 128 + el;
          const f32x4 gg = *(const f32x4*)(rn_g + e0), bb = *(const f32x4*)(rn_b + e0);
          const u32x2 graw = *(const u32x2*)(rg + (size_t)qrow * 512 + e0);
          float gt[4] = {__uint_as_float(graw[0] << 16), __uint_as_float(graw[0] & 0xffff0000u), __uint_as_float(graw[1] << 16), __uint_as_float(graw[1] & 0xffff0000u)};
          float o[4];
#pragma unroll
          for (int j = 0; j < 4; ++j) { const float yn = (acc[eb][4 * g4 + j] - mu) * rs * gg[j] + bb[j]; o[j] = gt[j] * __builtin_amdgcn_rcpf(1.f + __expf(-gt[j])) * yn; }
          u32x2 wv; wv[0] = pack2(o[0], o[1]); wv[1] = pack2(o[2], o[3]);
          *(u32x2*)(stg + r * 272 + el * 2) = wv; }
    }
  }
  __syncthreads();
  if (grp == 0) {
    const unsigned char* stg = (const unsigned char*)(comb + (size_t)nb * 64 * 64);
#pragma unroll
    for (int k = 0; k < 8; ++k) { const int chunk = lane + 64 * k, rw = chunk >> 4, c16 = chunk & 15; const int orow = ret_row(b, c, 32 * nb + rw);
      if (orow >= 0) *(u32x4*)(y + (size_t)orow * 1024 + 512 + h * 128 + c16 * 8) = *(const u32x4*)(stg + rw * 272 + c16 * 16); }
  }
  __syncthreads();
}

DI void attn_unit(const bf16_t* __restrict__ qf, const bf16_t* __restrict__ kf, const bf16_t* __restrict__ kvraw, bf16_t* y, const float* __restrict__ mo_g, int b, int h, int qt) {
  const int TX = opq((int)threadIdx.x);
  extern __shared__ __attribute__((aligned(16))) unsigned char smem[];
  constexpr int KB = 25600, VB = 20480;
  float* comb = (float*)smem;
  const int tid = TX, lane = tid & 63, w = tid >> 6, qb = w & 3, grp = w >> 2, r = lane & 31, hh = lane >> 5;
#define q4 ((lane & 15) >> 2)
#define p4 (lane & 3)
#define blk ((lane >> 4) & 1)
  const int qrow0 = qt < 0 ? MREAL + 16 * b : b * 2048 + 128 * qt;
  const int ql = 32 * qb + r;
  bf16x8 qfr[12];
  { const bf16_t* qp = qf + ((size_t)(qrow0 + ql) * 4 + h) * 192 + 8 * hh;
#pragma unroll
    for (int s = 0; s < 12; ++s) qfr[s] = *(const bf16x8*)(qp + 16 * s); }
  f32x16 oacc[4];
#pragma unroll
  for (int db = 0; db < 4; ++db)
#pragma unroll
    for (int i = 0; i < 16; ++i) oacc[db][i] = 0.f;
  float mrun = -1e30f, lsum = 0.f;
  const int ntile = qt < 0 ? 1 : 2 * qt + 3;
  u32x4 kA[3], vA[2];
#define ATT_LOAD(KR, VR, ti_) do { const int row0_ = (ti_) == 0 ? MREAL + 16 * b : b * 2048 + 64 * ((ti_) - 1); \
    _Pragma("unroll") for (int i = 0; i < 3; ++i) { const int idx = tid + 512 * i, key = idx / 24, ch = idx % 24; KR[i] = ((ti_) == 0 && key >= 16) ? (u32x4){0u, 0u, 0u, 0u} : *(const u32x4*)(kf + ((size_t)(row0_ + key) * 4 + h) * 192 + ch * 8); } \
    _Pragma("unroll") for (int i = 0; i < 2; ++i) { const int idx = tid + 512 * i, key = idx >> 4, ch = idx & 15; VR[i] = ((ti_) == 0 && key >= 16) ? (u32x4){0u, 0u, 0u, 0u} : *(const u32x4*)(kvraw + (size_t)(row0_ + key) * 1024 + h * 256 + 128 + ch * 8); } } while (0)
#define ATT_WRITE(KR, VR, ti_) do { unsigned char* Kw = smem + ((ti_) & 1) * KB; unsigned char* Vw = smem + 2 * KB + ((ti_) % 3) * VB; \
    _Pragma("unroll") for (int i = 0; i < 3; ++i) { const int idx = tid + 512 * i, key = idx / 24, ch = idx % 24; *(u32x4*)(Kw + (key * 200 + ch * 8) * 2) = KR[i]; } \
    _Pragma("unroll") for (int i = 0; i < 2; ++i) { const int idx = tid + 512 * i, key = idx >> 4, ch = idx & 15; *(u32x4*)(Vw + (key * 160 + ch * 8) * 2) = VR[i]; } } while (0)
#define ATT_S(ti) do { \
    const unsigned char* Ks = smem + ((ti) & 1) * KB; \
    _Pragma("unroll") for (int i = 0; i < 16; ++i) x[i] = 0.f; \
    { const unsigned char* kp = Ks + ((32 * grp + r) * 200 + 8 * hh) * 2; \
      __builtin_amdgcn_s_setprio(1); \
      _Pragma("unroll") for (int s = 0; s < 12; ++s) { const bf16x8 a = *(const bf16x8*)(kp + 32 * s); x = mfma32(a, qfr[s], x); } \
      __builtin_amdgcn_s_setprio(0); } \
    if ((ti) == 0) { \
      _Pragma("unroll") for (int i = 0; i < 16; ++i) { const int kl = 32 * grp + crow(i, hh); if (!(kl < 16 && (qt >= 0 || kl <= ql))) x[i] = -INFINITY; } \
    } else if ((ti) - 1 >= 2 * qt) { \
      const int koff = 64 * ((ti) - 1 - 2 * qt) + 32 * grp; \
      _Pragma("unroll") for (int i = 0; i < 16; ++i) { if (koff + crow(i, hh) > ql) x[i] = -INFINITY; } \
    } } while (0)
#define ATT_SOFT() do { \
    float mx = -INFINITY; \
    _Pragma("unroll") for (int i = 0; i < 16; ++i) mx = fmaxf(mx, x[i]); \
    mx = fmaxf(mx, __shfl_xor(mx, 32)); \
    const float mn = (mx > mrun + 8.f) ? mx : mrun; \
    const float alpha = fexp2(mrun - mn); \
    const bool resc = __any(mn != mrun); \
    mrun = mn; \
    float ps = 0.f; \
    _Pragma("unroll") for (int i = 0; i < 16; ++i) { const float pv = fexp2(x[i] - mn); x[i] = pv; ps += pv; } \
    lsum = lsum * alpha + ps; \
    if (resc) { _Pragma("unroll") for (int db = 0; db < 4; ++db) _Pragma("unroll") for (int i = 0; i < 16; ++i) oacc[db][i] *= alpha; } \
    pk[0] = pack8(x, 0); pk[1] = pack8(x, 1); } while (0)
#define ATT_PV(ti) do { \
    const unsigned char* Vs = smem + 2 * KB + ((ti) % 3) * VB; \
    __builtin_amdgcn_s_setprio(1); \
    _Pragma("unroll") for (int db = 0; db < 4; ++db) _Pragma("unroll") for (int s2 = 0; s2 < 2; ++s2) { const int key0 = 32 * grp + 16 * s2 + 4 * hh + q4; \
        const unsigned char* pa = Vs + (key0 * 160 + 32 * db + 16 * blk + 4 * p4) * 2; \
        const bf16x8 a = tr8(pa, pa + 8 * 160 * 2); oacc[db] = mfma32(a, pk[s2], oacc[db]); } \
    __builtin_amdgcn_s_setprio(0); } while (0)
#define ATT_COMPUTE(ti) do { f32x16 x; if (grp == 0) { ATT_S(ti); ATT_SOFT(); ATT_PV(ti); } else { if ((ti) > 0) ATT_PV((ti) - 1); ATT_S(ti); ATT_SOFT(); } } while (0)
  bf16x8 pk[2];
  ATT_LOAD(kA, vA, 0);
  ATT_WRITE(kA, vA, 0);
  __syncthreads();
  for (int ti = 0; ti < ntile; ++ti) {
    if (ti + 1 < ntile) ATT_LOAD(kA, vA, ti + 1);
    ATT_COMPUTE(ti);
    if (ti + 1 < ntile) ATT_WRITE(kA, vA, ti + 1);
    __syncthreads();
  }
  if (grp == 1) ATT_PV(ntile - 1);
  __syncthreads();
#undef ATT_S
#undef q4
#undef p4
#undef blk
#undef ATT_SOFT
#undef ATT_PV
#undef ATT_COMPUTE
#undef ATT_LOAD
#undef ATT_WRITE
  const float lt = lsum + __shfl_xor(lsum, 32);
  float* cb = comb + (size_t)qb * 66 * 64 + lane;
  if (grp == 1) {
#pragma unroll
    for (int db = 0; db < 4; ++db)
#pragma unroll
      for (int i = 0; i < 16; ++i) cb[(db * 16 + i) * 64] = oacc[db][i];
    cb[64 * 64] = mrun; cb[65 * 64] = lt;
  }
  __syncthreads();
  if (grp == 0) {
    const float m1 = cb[64 * 64], l1 = cb[65 * 64];
    const float mt = fmaxf(mrun, m1), a0 = fexp2(mrun - mt), a1 = fexp2(m1 - mt);
    const float inv = 1.f / (lt * a0 + l1 * a1);
    float ss = 0.f;
#pragma unroll
    for (int db = 0; db < 4; ++db)
#pragma unroll
      for (int i = 0; i < 16; ++i) { const float o = (oacc[db][i] * a0 + cb[(db * 16 + i) * 64] * a1) * inv; oacc[db][i] = o; ss += o * o; }
    ss += __shfl_xor(ss, 32);
    const float rs = rsqrtf(ss * (1.f / 128.f) + EPSN);
    if (qt >= 0 || ql < 16) {
      const size_t row = (size_t)(qrow0 + ql);
#pragma unroll
      for (int db = 0; db < 4; ++db)
#pragma unroll
        for (int g4 = 0; g4 < 4; ++g4) { const int d0 = h * 128 + 32 * db + 8 * g4 + 4 * hh; const f32x4 gg = *(const f32x4*)(mo_g + d0);
          u32x2 wv; wv[0] = pack2(oacc[db][4 * g4] * rs * gg[0], oacc[db][4 * g4 + 1] * rs * gg[1]); wv[1] = pack2(oacc[db][4 * g4 + 2] * rs * gg[2], oacc[db][4 * g4 + 3] * rs * gg[3]);
          *(u32x2*)(y + row * 1024 + d0) = wv; }
    }
  }
  __syncthreads();
}

#define XB_TMO      128
#define XB_XCNT(j)  (256  + 64 * (j))
#define XB_XSUB(j)  (1280 + 64 * (j))
#define XB_XGEN(j)  (2304 + 64 * (j))
#define XB_TOP      3328
#define XB_TOPGEN   3392
#define XCD_BAR_WORDS 3456
#define XB_SPIN_CAP (1u << 18)
#define LAS __attribute__((address_space(3)))
DI unsigned xb_ld(unsigned* p)              { return __hip_atomic_load(p, __ATOMIC_RELAXED, __HIP_MEMORY_SCOPE_AGENT); }
DI unsigned xb_add(unsigned* p, unsigned v) { return __hip_atomic_fetch_add(p, v, __ATOMIC_RELAXED, __HIP_MEMORY_SCOPE_AGENT); }
DI unsigned xb_xcc_id() { return (unsigned)__builtin_amdgcn_s_getreg((3 << 11) | 20) & 0xFu; }
#define XB_SPIN(cond, bar) do { unsigned _sp = 0; while (cond) { __builtin_amdgcn_s_sleep(1); \
    if ((++_sp & 255u) == 0u) { if (xb_ld(&(bar)[XB_TMO])) break; if (_sp > XB_SPIN_CAP) { atomicAdd(&(bar)[XB_TMO], 1u); break; } } } } while (0)
struct XcdBarrier { volatile LAS unsigned* st; };
DI XcdBarrier xcd_barrier_post(unsigned* bar, volatile LAS unsigned* st) {
  XcdBarrier b; b.st = st;
  if (threadIdx.x == 0) { const unsigned x = xb_xcc_id(); st[2] = x; (void)xb_add(&bar[XB_XCNT(x)], 1u); }
  return b;
}
DI void xcd_barrier_complete(unsigned* bar, unsigned x, unsigned& nloc, unsigned& nx) {
  const unsigned G = gridDim.x * gridDim.y * gridDim.z;
  unsigned sum, cnt, mine, sp = 0u;
  for (;;) {
    sum = 0u; cnt = 0u; mine = 0u;
#pragma unroll
    for (unsigned j = 0; j < 16; ++j) { const unsigned c = xb_ld(&bar[XB_XCNT(j)]); sum += c; cnt += (c > 0u) ? 1u : 0u; mine = (j == x) ? c : mine; }
    if (sum == G) break;
    __builtin_amdgcn_s_sleep(1);
    if ((++sp & 255u) == 0u) { if (xb_ld(&bar[XB_TMO])) break; if (sp > XB_SPIN_CAP) { atomicAdd(&bar[XB_TMO], 1u); break; } }
  }
  nloc = mine > 0u ? mine : 1u; nx = cnt > 0u ? cnt : 1u;
}
DI void xcd_barrier(const XcdBarrier& b, unsigned* bar) {
  asm volatile("s_waitcnt vmcnt(0)" ::: "memory");
  __syncthreads();
  if (threadIdx.x == 0) {
    __builtin_amdgcn_s_waitcnt(0);
    unsigned nloc = b.st[0], nx = b.st[1]; const unsigned bx = b.st[2];
    if (nloc == 0u) { xcd_barrier_complete(bar, bx, nloc, nx); b.st[0] = nloc; b.st[1] = nx; }
    const unsigned old = xb_add(&bar[XB_XSUB(bx)], 1u);
    const unsigned gen = old / nloc;
    if (old + 1u == (gen + 1u) * nloc) {
      __builtin_amdgcn_fence(__ATOMIC_RELEASE, "agent");
      asm volatile("s_waitcnt vmcnt(0)" ::: "memory");
      const unsigned og = xb_add(&bar[XB_TOP], 1u);
      const unsigned tg = og / nx;
      if (og + 1u == (tg + 1u) * nx) xb_add(&bar[XB_TOPGEN], 1u);
      else XB_SPIN(xb_ld(&bar[XB_TOPGEN]) == tg, bar);
      __builtin_amdgcn_fence(__ATOMIC_ACQUIRE, "agent");
      xb_add(&bar[XB_XGEN(bx)], 1u);
      asm volatile("s_waitcnt vmcnt(0)" ::: "memory");
    } else {
      XB_SPIN(xb_ld(&bar[XB_XGEN(bx)]) == gen, bar);
      __builtin_amdgcn_fence(__ATOMIC_ACQUIRE, "agent");
      asm volatile("s_waitcnt vmcnt(0)" ::: "memory");
    }
  }
  __syncthreads();
}

__global__ void __launch_bounds__(512) fwd_megakernel(Params p) {
  cg::grid_group grid = cg::this_grid();
  unsigned zoff = 0;
#define ws (p.ws + zoff)
#define Win ((bf16_t*)(ws + O_WIN))
#define Wqb ((bf16_t*)(ws + O_WQB))
#define Wkvb ((bf16_t*)(ws + O_WKVB))
#define Wout ((bf16_t*)(ws + O_WOUT))
#define Wgu ((bf16_t*)(ws + O_WGU))
#define Wdn ((bf16_t*)(ws + O_WDN))
#define hx ((float*)(ws + O_HX))
#define z ((bf16_t*)(ws + O_Z))
#define act ((bf16_t*)(ws + O_Z))
#define kvraw ((bf16_t*)(ws + O_KVRAW))
#define kst ((bf16_t*)(ws + O_KST))
#define qraw ((bf16_t*)(ws + O_QRAW))
#define y ((bf16_t*)(ws + O_Y))
#define hb ((bf16_t*)(ws + O_HB))
#define qf ((bf16_t*)(ws + O_QF))
#define cn ((bf16_t*)(ws + O_CN))
#define rq ((bf16_t*)(ws + O_RQ))
#define rk ((bf16_t*)(ws + O_RK))
#define rv ((bf16_t*)(ws + O_RV))
#define rg ((bf16_t*)(ws + O_RG))
#define kpe ((bf16_t*)(ws + O_KPE))
#define kss ((float*)(ws + O_KSS2))
#define cqss ((float*)(ws + O_CQSS))
#define ckvss ((float*)(ws + O_CKVSS))
#define kf ((bf16_t*)(ws + O_KF))
#define rss ((float*)(ws + O_RSS))
#define rssm ((float*)(ws + O_RSSM))
#define barw ((unsigned*)(ws + O_BAR))
#define SYNC() do { xcd_barrier(xb, barw); asm volatile("" : "+s"(zoff)); } while (0)
  const int G = gridDim.x, bid = blockIdx.x;
  bf16_t* const ds = (bf16_t*)p.out;
  extern __shared__ __attribute__((aligned(16))) unsigned char smem_k[];
  volatile LAS unsigned* xst = (volatile LAS unsigned*)(smem_k + 131072);
  if (threadIdx.x < 4) xst[threadIdx.x] = 0u;
  if (p.out == nullptr) grid.sync();
  __syncthreads();
  const XcdBarrier xb = xcd_barrier_post(barw, xst);

  conv_w(p.w_in, 1024, 2624, Win, 2816, 2, p.attn_g, bid, G);
  conv_w(p.w_qb, 256, 768, Wqb, 1024, 3, p.qa_g, bid, G);
  conv_w(p.w_kvb, 256, 1024, Wkvb, 1024, 0, p.kva_g, bid, G);
  conv_w(p.w_out, 1024, 1024, Wout, 1024, 0, nullptr, bid, G);
  phase_init(p, hb, hx, rss, rssm);
  SYNC();
  for (int layer = 0; layer < 2; ++layer) {
    { const G1Out go{cn, rq, rk, rv, rg, kpe, cqss, ckvss, kss, p.k_g + layer * 192};
      gemm_phase<EpiG1, true>(layer == 0 ? hb : ds, 1024, Win, 1024, 64, 11, EpiG1{go, rss});
      skinny_phase2<3>(layer == 0 ? hb : ds, 1024, Win, 1024, 44, nullptr, rssm, &go); }
    SYNC();
    for (int u = bid; u < 1056; u += G) {
      if (u < 256) gemm_tile<EpiQ, true>(cn, 512, Wqb, 256, u >> 2, u & 3, EpiQ{qf, cqss, p.q_g + layer * 192});
      else if (u < 512) { const int t = u - 256; gemm_tile<EpiKV, true>(cn + 256, 512, Wkvb, 256, t >> 2, t & 3, EpiKV{kf, kvraw, kpe, kss, ckvss, p.k_g + layer * 192}); }
      else { const int t = u - 512, bh = t / 17, c = t % 17; kvc_unit(rk, rv, kst, bh >> 2, bh & 3, c); }
    }
    skinny_phase<0>(cn, 512, Wqb, 256, 64, qraw - (size_t)MREAL * 1024, 1024, hx, cqss, 8, 2, 1.f / 256.f, nullptr);
    skinny_phase<0>(cn + 256, 512, Wkvb, 256, 64, kvraw, 1024, hx, ckvss, 8, 2, 1.f / 256.f, nullptr);
    SYNC();
    phase_r3(qraw, kvraw, kpe, kss, p.q_g + layer * 192, p.k_g + layer * 192, qf, kf);
    phase_scan(kst);
    SYNC();
    for (int u = bid; u < 832; u += G) {
      if (u < 256) { const int bh = ((u & 7) << 2) | (u >> 6), xq = (u >> 3) & 7;
        attn_unit(qf, kf, kvraw, y, p.mo_g + layer * 512, bh >> 2, bh & 3, 15 - xq);
        attn_unit(qf, kf, kvraw, y, p.mo_g + layer * 512, bh >> 2, bh & 3, xq); }
      else if (u < 800) { const int t = u - 256, bh = t & 31, c = 16 - (t >> 5); ret_unit(rq, rk, rv, rg, kst, y, p.rn_g + layer * 512, p.rn_b + layer * 512, bh >> 2, bh & 3, c); }
      else { const int bh = u - 800; attn_unit(qf, kf, kvraw, y, p.mo_g + layer * 512, bh >> 2, bh & 3, -1); }
    }
    SYNC();
    conv_w(p.w_gu + (size_t)layer * 1024 * 5632, 1024, 5632, Wgu, 5632, 1, p.ffn_g + layer * 1024, bid, G);
    gemm_phase<EpiRes, true>(y, 1024, Wout, 1024, 64, 4, EpiRes{layer == 0 ? p.x : nullptr, ds, nullptr, hb, rss});
    for (int t = bid; t < 256; t += G) skinny_res_task<4>(y, 1024, Wout, 1024, t, hb, hx, rssm);
    SYNC();
    gemm_phase<EpiSwiglu, true>(hb, 1024, Wgu, 1024, 64, 22, EpiSwiglu{act, rss});
    skinny_phase2<2>(hb, 1024, Wgu, 1024, 88, act, rssm, nullptr);
    conv_w(p.w_dn + (size_t)layer * 2816 * 1024, 2816, 1024, Wdn, 1024, 0, nullptr, bid - G / 2, G - G / 2);
    if (layer == 0) {
      conv_w(p.w_in + (size_t)1024 * 2624, 1024, 2624, Win, 2816, 2, p.attn_g + 1024, bid - G / 2, G - G / 2);
      conv_w(p.w_qb + (size_t)256 * 768, 256, 768, Wqb, 1024, 3, p.qa_g + 256, bid - G / 2, G - G / 2);
      conv_w(p.w_kvb + (size_t)256 * 1024, 256, 1024, Wkvb, 1024, 0, p.kva_g + 256, bid - G / 2, G - G / 2);
      conv_w(p.w_out + (size_t)1024 * 1024, 1024, 1024, Wout, 1024, 0, nullptr, bid - G / 2, G - G / 2);
    }
    SYNC();
    gemm_phase<EpiRes, true>(act, DFF, Wdn, DFF, 64, 4, EpiRes{nullptr, hb, layer == 1 ? p.out : nullptr, layer == 0 ? ds : hb, rss});
    if (layer == 0) for (int t = bid; t < 256; t += G) skinny_res_task<11>(act, DFF, Wdn, DFF, t, ds, hx, rssm);
    if (layer == 0) SYNC();
  }
}

#undef Win
#undef Wqb
#undef Wkvb
#undef Wout
#undef Wgu
#undef Wdn
#undef hx
#undef z
#undef act
#undef kvraw
#undef kst
#undef qraw
#undef y
#undef hb
#undef qf
#undef cn
#undef rq
#undef rk
#undef rv
#undef rg
#undef kpe
#undef kss
#undef kf
#undef rss
#undef rssm
#undef barw
#undef SYNC
#undef ws
extern "C" void kernel_launch(void* const* d_in, const int* in_sizes, int n_in, void* d_out, int out_size, void* d_ws, size_t ws_size, hipStream_t stream) {
  constexpr size_t kDynLds = 131072 + 256 + 1024;
  static int grid_blocks = 0;
  if (!grid_blocks) {
    int dev = 0, cus = 0, per_cu = 0;
    hipGetDevice(&dev);
    hipDeviceGetAttribute(&cus, hipDeviceAttributeMultiprocessorCount, dev);
    hipFuncSetAttribute((const void*)fwd_megakernel, hipFuncAttributeMaxDynamicSharedMemorySize, (int)kDynLds);
    hipOccupancyMaxActiveBlocksPerMultiprocessor(&per_cu, fwd_megakernel, 512, kDynLds);
    if (per_cu < 1) per_cu = 1;
    grid_blocks = cus * per_cu;
  }
  Params p{};
  p.x = (const float*)d_in[0]; p.meta = (const float*)d_in[1]; p.attn_g = (const float*)d_in[2]; p.w_in = (const float*)d_in[3];
  p.qa_g = (const float*)d_in[4]; p.w_qb = (const float*)d_in[5]; p.kva_g = (const float*)d_in[6]; p.w_kvb = (const float*)d_in[7];
  p.q_g = (const float*)d_in[8]; p.k_g = (const float*)d_in[9]; p.mo_g = (const float*)d_in[10]; p.rn_g = (const float*)d_in[11]; p.rn_b = (const float*)d_in[12];
  p.w_out = (const float*)d_in[13]; p.ffn_g = (const float*)d_in[14]; p.w_gu = (const float*)d_in[15]; p.w_dn = (const float*)d_in[16];
  p.out = (float*)d_out; p.ws = (unsigned char*)d_ws;
  if (ws_size < WS_NEED) fprintf(stderr, "workspace too small: %zu < %zu\n", ws_size, (size_t)WS_NEED);
  hipMemsetAsync((unsigned char*)d_ws + O_BAR, 0, XCD_BAR_WORDS * sizeof(unsigned), stream);
  void* args[] = {&p};
  hipError_t e = hipLaunchCooperativeKernel((const void*)fwd_megakernel, dim3(grid_blocks), dim3(512), args, kDynLds, stream);
  if (e != hipSuccess) fprintf(stderr, "cooperative launch failed: %s (grid %d)\n", hipGetErrorString(e), grid_blocks);
}
```
